# Optimizing an MI355X kernel written in HIP

```python
import jax, jax.numpy as jnp
from jax import lax
import numpy as np

D_MODEL = 1024
BATCH = 2
SEQ = 8192
DEPTH = 1

CHUNK = 64
POOL_GROUPS = 4
POOL_WINDOWS = (2, 4, 8, 16)
POOL_WIDTH = D_MODEL // 2
POOL_GROUP_DIM = POOL_WIDTH // POOL_GROUPS
SB_HEAD_DIM = 64
SB_HEADS = D_MODEL // 128
SB_WIDTH = SB_HEADS * SB_HEAD_DIM
SB_BLOCK = 128
MEM_LEN = 256
X_HEADS = 4
X_HEAD_DIM = D_MODEL // 16
X_WIDTH = X_HEADS * X_HEAD_DIM
N_BRANCHES = 3
D_FF = -(-8 * D_MODEL // (3 * 256)) * 256
RMS_EPS = 1e-6
IN_WIDTH = POOL_WIDTH + 3 * SB_WIDTH + X_WIDTH + N_BRANCHES * D_MODEL

kernel_name = "hybrid_pool_stickbreak_memx_block"


def rmsnorm(x, g):
    xf = x.astype(jnp.float32)
    y = xf * lax.rsqrt(jnp.mean(xf * xf, axis=-1, keepdims=True) + RMS_EPS) * g.astype(jnp.float32)
    return y.astype(x.dtype)


def pool_mixer(p, w_mix, scale):
    b, s, _ = p.shape
    pg = p.astype(jnp.float32).reshape(b, s, POOL_GROUPS, POOL_GROUP_DIM)
    c = jnp.concatenate([jnp.zeros((b, 1, POOL_GROUPS, POOL_GROUP_DIM), jnp.float32),
                         jnp.cumsum(pg, axis=1)], axis=1)
    windows = jnp.array(POOL_WINDOWS, jnp.int32)
    t1 = jnp.arange(1, s + 1, dtype=jnp.int32)[:, None]
    lo = jnp.maximum(t1 - windows[None, :], 0)
    g_idx = jnp.arange(POOL_GROUPS, dtype=jnp.int32)[None, :]
    c_lo = c[:, lo, g_idx]
    count = jnp.minimum(t1, windows[None, :]).astype(jnp.float32)
    mixed = (c[:, 1:] - c_lo) / count[None, :, :, None] - pg
    mixed = mixed.astype(p.dtype)
    y = jnp.einsum('bsgc,gcd->bsgd', mixed, w_mix)
    return y.reshape(b, s, POOL_WIDTH) * scale


def stick_breaking_attention(q, k, v):
    b, s, h, dh = q.shape
    nb = s // SB_BLOCK
    scale = 1.0 / float(np.sqrt(dh))
    kf = k.astype(jnp.float32).transpose(0, 2, 1, 3)
    vf = v.astype(jnp.float32).transpose(0, 2, 1, 3)
    qb = q.astype(jnp.float32).transpose(0, 2, 1, 3).reshape(b, h, nb, SB_BLOCK, dh)
    qb = qb.transpose(2, 0, 1, 3, 4)
    key_pos = jnp.arange(s, dtype=jnp.int32)[None, :]

    def one_block(args):
        q_blk, bi = args
        z = jnp.einsum('bhqd,bhkd->bhqk', q_blk, kf) * scale
        qpos = bi * SB_BLOCK + jnp.arange(SB_BLOCK, dtype=jnp.int32)[:, None]
        mask = key_pos < qpos
        log1m = jnp.where(mask, jax.nn.log_sigmoid(-z), 0.0)
        excl = lax.cumsum(log1m, axis=3, reverse=True) - log1m
        a = jnp.where(mask, jnp.exp(jax.nn.log_sigmoid(z) + excl), 0.0)
        return jnp.einsum('bhqk,bhkd->bhqd', a, vf)

    out = lax.map(one_block, (qb, jnp.arange(nb, dtype=jnp.int32)))
    out = out.transpose(1, 0, 3, 2, 4).reshape(b, s, h * dh)
    return out.astype(q.dtype)


def memory_cross_attention(q, mem_n, w_mem_kv):
    b, s = q.shape[:2]
    m = mem_n.shape[1]
    kv = (mem_n @ w_mem_kv).reshape(b, m, 2, X_HEADS, X_HEAD_DIM)
    mk, mv = kv[:, :, 0], kv[:, :, 1]
    scores = jnp.einsum('bshd,bmhd->bhsm', q.astype(jnp.float32), mk.astype(jnp.float32))
    p = jax.nn.softmax(scores / float(np.sqrt(X_HEAD_DIM)), axis=-1)
    out = jnp.einsum('bhsm,bmhd->bshd', p, mv.astype(jnp.float32))
    return out.reshape(b, s, X_WIDTH).astype(q.dtype)


def setup_inputs(seed: int = 0) -> dict:
    key = jax.random.key(seed)
    ks = jax.random.split(key, 20)
    f32 = jnp.float32

    def nrm(k, shape, fan_in):
        return jax.random.normal(k, shape, f32) * (fan_in ** -0.5)

    def gain(k, shape):
        return 1.0 + 0.02 * jax.random.normal(k, shape, f32)

    L = DEPTH
    return {
        "x": jax.random.normal(ks[0], (BATCH, SEQ, D_MODEL), f32),
        "mem": jax.random.normal(ks[1], (BATCH, MEM_LEN, D_MODEL), f32),
        "norm_mix_pre": gain(ks[2], (L, D_MODEL)),
        "w_in": nrm(ks[3], (L, D_MODEL, IN_WIDTH), D_MODEL),
        "w_pool_mix": nrm(ks[4], (L, POOL_GROUPS, POOL_GROUP_DIM, POOL_GROUP_DIM), POOL_GROUP_DIM),
        "pool_scale": gain(ks[5], (L, POOL_WIDTH)),
        "w_pool_o": nrm(ks[6], (L, POOL_WIDTH, D_MODEL), POOL_WIDTH),
        "w_sb_o": nrm(ks[7], (L, SB_WIDTH, D_MODEL), SB_WIDTH),
        "norm_mem": gain(ks[8], (L, D_MODEL)),
        "w_mem_kv": nrm(ks[9], (L, D_MODEL, 2 * X_WIDTH), D_MODEL),
        "w_x_o": nrm(ks[10], (L, X_WIDTH, D_MODEL), X_WIDTH),
        "w_out": nrm(ks[11], (L, D_MODEL, D_MODEL), D_MODEL),
        "norm_mix_post": gain(ks[12], (L, D_MODEL)),
        "norm_ffn_pre": gain(ks[13], (L, D_MODEL)),
        "w_ffn_in": nrm(ks[14], (L, D_MODEL, 2 * D_FF), D_MODEL),
        "w_ffn_out": nrm(ks[15], (L, D_FF, D_MODEL), D_FF),
        "norm_ffn_post": gain(ks[16], (L, D_MODEL)),
    }


def reference(x, mem, norm_mix_pre, w_in, w_pool_mix, pool_scale, w_pool_o, w_sb_o,
              norm_mem, w_mem_kv, w_x_o, w_out, norm_mix_post, norm_ffn_pre,
              w_ffn_in, w_ffn_out, norm_ffn_post):
    b, s, d = x.shape
    h = x
    for l in range(DEPTH):
        n = rmsnorm(h, norm_mix_pre[l])
        proj = n @ w_in[l]
        o0 = POOL_WIDTH
        o1 = o0 + 3 * SB_WIDTH
        o2 = o1 + X_WIDTH
        p_in = proj[..., :o0]
        qkv = proj[..., o0:o1].reshape(b, s, 3, SB_HEADS, SB_HEAD_DIM)
        xq = proj[..., o1:o2].reshape(b, s, X_HEADS, X_HEAD_DIM)
        gates = jax.nn.sigmoid(proj[..., o2:].astype(jnp.float32)).reshape(b, s, N_BRANCHES, d)

        y_pool = pool_mixer(p_in, w_pool_mix[l], pool_scale[l]) @ w_pool_o[l]
        y_sb = stick_breaking_attention(qkv[:, :, 0], qkv[:, :, 1], qkv[:, :, 2]) @ w_sb_o[l]
        mem_n = rmsnorm(mem, norm_mem[l])
        y_x = memory_cross_attention(xq, mem_n, w_mem_kv[l]) @ w_x_o[l]

        merged = (gates[:, :, 0] * y_pool.astype(jnp.float32)
                  + gates[:, :, 1] * y_sb.astype(jnp.float32)
                  + gates[:, :, 2] * y_x.astype(jnp.float32)).astype(h.dtype)
        h = h + rmsnorm(merged @ w_out[l], norm_mix_post[l])

        n2 = rmsnorm(h, norm_ffn_pre[l])
        gu = n2 @ w_ffn_in[l]
        ff = (jax.nn.silu(gu[..., :D_FF]) * gu[..., D_FF:]) @ w_ffn_out[l]
        h = h + rmsnorm(ff, norm_ffn_post[l])
    return h
```

```cpp
#include <hip/hip_runtime.h>
#include <hip/hip_cooperative_groups.h>
#include <cstdio>
#include <cstdint>
namespace cg = cooperative_groups;
namespace pg8 {
#define PG8_LAS __attribute__((address_space(3)))
typedef unsigned short bf16_t;
typedef short bf16x8 __attribute__((ext_vector_type(8)));
typedef float f32x4 __attribute__((ext_vector_type(4)));
typedef unsigned u32x4 __attribute__((ext_vector_type(4)));
constexpr int BM = 256, BK = 64, HALF = 128, HTB = HALF * BK * 2  , STAGE_BYTES = 8 * HTB, NXCD = 8, WGM = 8;

__host__ __device__ __forceinline__ int lds_byte(int r, int c) { const int st = (r >> 4) * 2 + (c >> 5), rr = r & 15, cc = c & 31, ob = rr * 64 + cc * 2; return st * 1024 + (ob ^ (((ob >> 9) & 1) << 5)); }
__host__ __device__ __forceinline__ void stage_rc(int b, int& R, int& C) { const int st = b / 1024, sb = b % 1024, swz = sb ^ (((sb >> 9) & 1) << 5); R = (st >> 1) * 16 + swz / 64; C = (st & 1) * 32 + (swz % 64) / 2; }
__host__ __device__ __forceinline__ int perm32(int rho) { const int n = rho >> 4, i = rho & 15; return 8 * (i >> 2) + 4 * n + (i & 3); }

struct Unit { int pm, pn; };
struct Gemm { const bf16_t* A; const bf16_t* Bt; int M, N, K; };

struct StaticOrder {
    int nM, nN, nwg, G, c;
    __host__ __device__ void init(int M, int N, int G_, int c_) { nM = M / BM; nN = N / BM; nwg = nM * nN; G = G_; c = c_; }
    __host__ __device__ bool next(int i, Unit& u) const {
        const long L = (long)i * G + c; if (L >= nwg) return false;
        int wgid = (int)L; { const int q = nwg / NXCD, r = nwg % NXCD, xcd = wgid % NXCD, off = wgid / NXCD; wgid = (xcd < r ? xcd * (q + 1) : r * (q + 1) + (xcd - r) * q) + off; }
        const int nig = WGM * nN, gid = wgid / nig, fm = gid * WGM, gsz = (nM - fm) < WGM ? (nM - fm) : WGM;
        u.pm = fm + ((wgid % nig) % gsz); u.pn = (wgid % nig) / gsz; return true;
    }
    __device__ __forceinline__ void a_ready(const Unit&) const {}
    __device__ __forceinline__ void done(const Unit&) const {}
};


typedef float f32x2_t __attribute__((ext_vector_type(2)));
typedef __bf16 bf16x2_t __attribute__((ext_vector_type(2)));
__device__ __forceinline__ unsigned pk_bf16(float lo, float hi) { f32x2_t v = {lo, hi}; bf16x2_t b = __builtin_convertvector(v, bf16x2_t); return __builtin_bit_cast(unsigned, b); }
__device__ __forceinline__ float bf_lo(unsigned u) { return __uint_as_float(u << 16); }
__device__ __forceinline__ float bf_hi(unsigned u) { return __uint_as_float(u & 0xffff0000u); }
__device__ __forceinline__ float sigmoid_f(float x) { return __builtin_amdgcn_rcpf(1.0f + __expf(-x)); }

struct EpiProj {
    static constexpr bool PERM = true, AFTER_DRAIN = false;
    bf16_t* pq; bf16_t* gates; bf16_t* vt; bf16_t* mk; bf16_t* mvt; int kind;
    __device__ __forceinline__ void operator()(const f32x4 (&acc)[2][2][4][2], const Unit& u, int wr, int wc, int fr, int fq) const {
        int mode, ldc = 0, colt = 0, lgS = 0, H = 0; bf16_t* base;
        if (kind == 0) {
            if (u.pn >= 9) { mode = 1; base = gates; ldc = 3072; colt = (u.pn - 9) * 256; }
            else if (u.pn == 6 || u.pn == 7) { mode = 2; base = vt; colt = (u.pn - 6) * 256; lgS = 13; H = 8; }
            else { mode = 0; base = pq; ldc = 1792; colt = (u.pn == 8) ? 1536 : u.pn * 256; }
        } else {
            if (u.pn == 0) { mode = 0; base = mk; ldc = 256; colt = 0; }
            else { mode = 2; base = mvt; colt = 0; lgS = 8; H = 4; }
        }
        const int row0 = u.pm * BM + wr * 64 + fr;
        const int c0 = wc * 32 + 8 * fq;
        if (mode != 2) {
#pragma unroll
            for (int ai = 0; ai < 2; ++ai)
#pragma unroll
                for (int m = 0; m < 4; ++m) { bf16_t* rowp = base + (size_t)(row0 + ai * HALF + m * 16) * ldc + colt + c0;
#pragma unroll
                    for (int bj = 0; bj < 2; ++bj) { f32x4 v0 = acc[ai][bj][m][0], v1 = acc[ai][bj][m][1];
                        if (mode == 1) {
#pragma unroll
                            for (int j = 0; j < 4; ++j) { v0[j] = sigmoid_f(v0[j]); v1[j] = sigmoid_f(v1[j]); } }
                        u32x4 w; w.x = pk_bf16(v0[0], v0[1]); w.y = pk_bf16(v0[2], v0[3]); w.z = pk_bf16(v1[0], v1[1]); w.w = pk_bf16(v1[2], v1[3]);
                        *(u32x4*)(rowp + bj * HALF) = w; } }
        } else {
            const int S = 1 << lgS;
#pragma unroll
            for (int ai = 0; ai < 2; ++ai)
#pragma unroll
                for (int m = 0; m < 4; ++m) { const int row = row0 + ai * HALF + m * 16, b = row >> lgS, t = row & (S - 1);
#pragma unroll
                    for (int bj = 0; bj < 2; ++bj)
#pragma unroll
                        for (int n = 0; n < 2; ++n) { const f32x4 v = acc[ai][bj][m][n];
#pragma unroll
                            for (int j = 0; j < 4; ++j) { const int col = colt + bj * HALF + c0 + 4 * n + j, hh = col >> 6, d = col & 63;
                                const unsigned pk = pk_bf16(v[j], 0.f);
                                base[(((size_t)(b * H + hh) * 64 + d) << lgS) + t] = (bf16_t)(pk & 0xffffu); } } }
        }
    }
};
struct EpiGate {
    static constexpr bool PERM = true, AFTER_DRAIN = false;
    const bf16_t* gates; const bf16_t* pin; bf16_t* pout;
    __device__ __forceinline__ void operator()(const f32x4 (&acc)[2][2][4][2], const Unit& u, int wr, int wc, int fr, int fq) const {
        const int row0 = u.pm * BM + wr * 64 + fr, col0 = u.pn * BM + wc * 32 + 8 * fq;
#pragma unroll
        for (int ai = 0; ai < 2; ++ai)
#pragma unroll
            for (int m = 0; m < 4; ++m) { const size_t row = (size_t)(row0 + ai * HALF + m * 16);
#pragma unroll
                for (int bj = 0; bj < 2; ++bj) { const int col = col0 + bj * HALF;
                    const u32x4 g = *(const u32x4*)(gates + row * 3072 + col);
                    u32x4 p = {0u, 0u, 0u, 0u}; if (pin) p = *(const u32x4*)(pin + row * 1024 + col);
                    const f32x4 v0 = acc[ai][bj][m][0], v1 = acc[ai][bj][m][1];
                    u32x4 w;
                    w.x = pk_bf16(bf_lo(p.x) + bf_lo(g.x) * v0[0], bf_hi(p.x) + bf_hi(g.x) * v0[1]);
                    w.y = pk_bf16(bf_lo(p.y) + bf_lo(g.y) * v0[2], bf_hi(p.y) + bf_hi(g.y) * v0[3]);
                    w.z = pk_bf16(bf_lo(p.z) + bf_lo(g.z) * v1[0], bf_hi(p.z) + bf_hi(g.z) * v1[1]);
                    w.w = pk_bf16(bf_lo(p.w) + bf_lo(g.w) * v1[2], bf_hi(p.w) + bf_hi(g.w) * v1[3]);
                    *(u32x4*)(pout + row * 1024 + col) = w; } }
    }
};
struct EpiSwiGLU {
    static constexpr bool PERM = true, AFTER_DRAIN = false;
    bf16_t* O;
    __device__ __forceinline__ void operator()(const f32x4 (&acc)[2][2][4][2], const Unit& u, int wr, int wc, int fr, int fq) const {
        const int row0 = u.pm * BM + wr * 64 + fr, col0 = u.pn * HALF + wc * 32 + 8 * fq;
#pragma unroll
        for (int ai = 0; ai < 2; ++ai)
#pragma unroll
            for (int m = 0; m < 4; ++m) { const size_t row = (size_t)(row0 + ai * HALF + m * 16);
                float o[8];
#pragma unroll
                for (int n = 0; n < 2; ++n)
#pragma unroll
                    for (int j = 0; j < 4; ++j) { const float g = acc[ai][0][m][n][j], up = acc[ai][1][m][n][j]; o[4 * n + j] = g * sigmoid_f(g) * up; }
                u32x4 w; w.x = pk_bf16(o[0], o[1]); w.y = pk_bf16(o[2], o[3]); w.z = pk_bf16(o[4], o[5]); w.w = pk_bf16(o[6], o[7]);
                *(u32x4*)(O + row * 2816 + col0) = w; }
    }
};
struct EpiF32SS {
    static constexpr bool PERM = false, AFTER_DRAIN = false;
    float* O; float* SS;
    __device__ __forceinline__ void operator()(const f32x4 (&acc)[2][2][4][2], const Unit& u, int wr, int wc, int fr, int fq) const {
        const int row0 = u.pm * BM + wr * 64 + fr, col0 = u.pn * BM + wc * 32 + 4 * fq;
#pragma unroll
        for (int ai = 0; ai < 2; ++ai)
#pragma unroll
            for (int m = 0; m < 4; ++m) { const size_t row = (size_t)(row0 + ai * HALF + m * 16); float s = 0.f;
#pragma unroll
                for (int bj = 0; bj < 2; ++bj)
#pragma unroll
                    for (int n = 0; n < 2; ++n) { const f32x4 v = acc[ai][bj][m][n]; s += (v[0] * v[0] + v[1] * v[1]) + (v[2] * v[2] + v[3] * v[3]);
                        *(f32x4*)(O + row * 1024 + col0 + bj * HALF + n * 16) = v; }
                s += __shfl_xor(s, 16); s += __shfl_xor(s, 32);
                if (fq == 0) SS[row * 16 + u.pn * 4 + wc] = s; }
    }
};

template <class Epi, class Sched, bool ALIGN_EPI = false, bool SP2 = false>
__device__ __forceinline__ void gemm_phase(PG8_LAS unsigned char* lds, const Gemm g, const Sched& S, const Epi& E) {
    int tid_raw = threadIdx.x; asm volatile("" : "+v"(tid_raw));
    const int tid = tid_raw, wid = __builtin_amdgcn_readfirstlane(tid >> 6), lane = tid & 63, wr = wid >> 2, wc = wid & 3, fr = lane & 15, fq = lane >> 4;
    const int K = g.K, nt = K / BK;
    unsigned voffA[2], voffB[2];
#pragma unroll
    for (int i = 0; i < 2; ++i) { int R, C; stage_rc(tid * 16 + i * 8192, R, C); const int Rb = Epi::PERM ? ((R & ~31) + perm32(R & 31)) : R;
        voffA[i] = (unsigned)(R * K + C) * 2u; voffB[i] = (unsigned)(Rb * K + C) * 2u; }
    const size_t kstep = (size_t)(BK * 2);
    const size_t hstep = (size_t)HALF * K * 2;
    const size_t tstep = 2 * hstep;
    const unsigned ldsw = (unsigned)wid * 1024u;
    const int aoff = lds_byte(wr * 64 + fr, fq * 8), boff = lds_byte(wc * 32 + fr, fq * 8);
#define PG8_SA(b, h) (((b) * 2 + (h)) * HTB)
#define PG8_SB(b, h) ((4 + (b) * 2 + (h)) * HTB)
#define PG8_STAGE(bufoff, gbase, voff) do { _Pragma("unroll") for (int _i = 0; _i < 2; ++_i) \
        __builtin_amdgcn_global_load_lds((const unsigned*)((const char*)(gbase) + (voff)[_i]), (PG8_LAS unsigned*)(lds + (bufoff) + ldsw + _i * 8192), 16, 0, 0); } while (0)
#define PG8_LDA(dst, b, h) do { _Pragma("unroll") for (int m = 0; m < 4; ++m) _Pragma("unroll") for (int k = 0; k < 2; ++k) dst[m][k] = *(const PG8_LAS bf16x8*)(lds + PG8_SA(b, h) + aoff + m * 2048 + k * 1024); } while (0)
#define PG8_LDB(dst, b, h) do { _Pragma("unroll") for (int n = 0; n < 2; ++n) _Pragma("unroll") for (int k = 0; k < 2; ++k) dst[n][k] = *(const PG8_LAS bf16x8*)(lds + PG8_SB(b, h) + boff + n * 2048 + k * 1024); } while (0)
#define PG8_MMA(ai, bj, At, Bt) do { __builtin_amdgcn_s_setprio(1); _Pragma("unroll") for (int m = 0; m < 4; ++m) _Pragma("unroll") for (int n = 0; n < 2; ++n) _Pragma("unroll") for (int k = 0; k < 2; ++k) \
        acc[ai][bj][m][n] = __builtin_amdgcn_mfma_f32_16x16x32_bf16(Bt[n][k], At[m][k], acc[ai][bj][m][n], 0, 0, 0); __builtin_amdgcn_s_setprio(0); } while (0)
#define PG8_WAIT_V(n) asm volatile("s_waitcnt vmcnt(" #n ")" ::: "memory")
#define PG8_WAIT_L(n) asm volatile("s_waitcnt lgkmcnt(" #n ")" ::: "memory")
#define PG8_BAR __builtin_amdgcn_s_barrier()
#define PG8_SCHED __builtin_amdgcn_sched_barrier(0)
    Unit cur, nxt; int ui = 0;
    if (!S.next(0, cur)) return;
    f32x4 acc[2][2][4][2];
#pragma unroll
    for (int a = 0; a < 2; ++a)
#pragma unroll
        for (int b = 0; b < 2; ++b)
#pragma unroll
            for (int m = 0; m < 4; ++m)
#pragma unroll
                for (int n = 0; n < 2; ++n) acc[a][b][m][n] = (f32x4){0.f, 0.f, 0.f, 0.f};
    bf16x8 At[4][2], B0[2][2], B1[2][2];
    const char* cA = (const char*)g.A + (size_t)cur.pm * tstep; const char* cB = (const char*)g.Bt + (size_t)cur.pn * tstep;
    S.a_ready(cur);
    if constexpr (SP2) {
        PG8_STAGE(PG8_SB(0, 0), cB, voffB); PG8_STAGE(PG8_SB(0, 1), cB + hstep, voffB); PG8_STAGE(PG8_SA(0, 0), cA, voffA); PG8_STAGE(PG8_SA(0, 1), cA + hstep, voffA);
        if (wr == 1) PG8_BAR;
        PG8_WAIT_V(2); PG8_BAR;
        PG8_STAGE(PG8_SB(1, 0), cB + kstep, voffB); PG8_STAGE(PG8_SA(1, 0), cA + kstep, voffA); PG8_STAGE(PG8_SB(1, 1), cB + hstep + kstep, voffB);
        PG8_WAIT_V(6); PG8_BAR;
    } else {
        PG8_STAGE(PG8_SB(0, 0), cB, voffB); PG8_STAGE(PG8_SA(0, 0), cA, voffA); PG8_STAGE(PG8_SB(0, 1), cB + hstep, voffB); PG8_STAGE(PG8_SA(0, 1), cA + hstep, voffA);
        if (wr == 1) PG8_BAR;
        PG8_WAIT_V(4); PG8_BAR;
        PG8_STAGE(PG8_SB(1, 0), cB + kstep, voffB); PG8_STAGE(PG8_SA(1, 0), cA + kstep, voffA); PG8_STAGE(PG8_SB(1, 1), cB + hstep + kstep, voffB);
        PG8_WAIT_V(6); PG8_BAR;
    }
    for (;;) {
        const bool has_next = S.next(ui + 1, nxt);
        const char* nA = has_next ? (const char*)g.A + (size_t)nxt.pm * tstep : cA; const char* nB = has_next ? (const char*)g.Bt + (size_t)nxt.pn * tstep : cB;
        for (int t = 0; t < nt; t += 2) {
            const bool last = (t == nt - 2);
            const char* a1 = cA + (size_t)(t + 1) * kstep;
            const char* a2 = last ? nA : cA + (size_t)(t + 2) * kstep; const char* b2 = last ? nB : cB + (size_t)(t + 2) * kstep;
            const char* a3 = a2 + kstep; const char* b3 = b2 + kstep;
            if (last && has_next) S.a_ready(nxt);
            if constexpr (SP2) {
            PG8_LDB(B0, 0, 0); PG8_LDB(B1, 0, 1); PG8_SCHED; PG8_LDA(At, 0, 0); PG8_STAGE(PG8_SA(1, 1), a1 + hstep, voffA);
            PG8_WAIT_V(8); PG8_WAIT_L(0); PG8_BAR; PG8_MMA(0, 0, At, B0); PG8_MMA(0, 1, At, B1); PG8_BAR; PG8_SCHED;
            PG8_LDA(At, 0, 1); PG8_STAGE(PG8_SB(0, 0), b2, voffB); PG8_STAGE(PG8_SB(0, 1), b2 + hstep, voffB); PG8_STAGE(PG8_SA(0, 0), a2, voffA);
            PG8_WAIT_V(8); PG8_WAIT_L(0); PG8_BAR; PG8_MMA(1, 0, At, B0); PG8_MMA(1, 1, At, B1); PG8_BAR; PG8_SCHED;
            PG8_LDB(B0, 1, 0); PG8_LDB(B1, 1, 1); PG8_SCHED; PG8_LDA(At, 1, 0); PG8_STAGE(PG8_SA(0, 1), a2 + hstep, voffA);
            PG8_WAIT_V(8); PG8_WAIT_L(0); PG8_BAR; PG8_MMA(0, 0, At, B0); PG8_MMA(0, 1, At, B1); PG8_BAR; PG8_SCHED;
            PG8_LDA(At, 1, 1); PG8_STAGE(PG8_SB(1, 0), b3, voffB); PG8_STAGE(PG8_SB(1, 1), b3 + hstep, voffB); PG8_STAGE(PG8_SA(1, 0), a3, voffA);
            PG8_WAIT_V(8); PG8_WAIT_L(0); PG8_BAR; PG8_MMA(1, 0, At, B0); PG8_MMA(1, 1, At, B1); PG8_BAR; PG8_SCHED;
            } else {
            PG8_LDB(B0, 0, 0); PG8_SCHED; PG8_LDA(At, 0, 0); PG8_STAGE(PG8_SA(1, 1), a1 + hstep, voffA);
            PG8_WAIT_L(8); PG8_BAR; PG8_WAIT_L(0); PG8_MMA(0, 0, At, B0); PG8_BAR; PG8_SCHED;
            PG8_LDB(B1, 0, 1); PG8_STAGE(PG8_SB(0, 0), b2, voffB);
            PG8_BAR; PG8_WAIT_L(0); PG8_MMA(0, 1, At, B1); PG8_BAR;
            PG8_LDA(At, 0, 1); PG8_STAGE(PG8_SA(0, 0), a2, voffA);
            PG8_BAR; PG8_WAIT_L(0); PG8_MMA(1, 0, At, B0); PG8_BAR; PG8_SCHED;
            PG8_STAGE(PG8_SB(0, 1), b2 + hstep, voffB);
            PG8_WAIT_V(6); PG8_BAR; PG8_MMA(1, 1, At, B1); PG8_BAR;
            PG8_LDB(B0, 1, 0); PG8_SCHED; PG8_LDA(At, 1, 0); PG8_STAGE(PG8_SA(0, 1), a2 + hstep, voffA);
            PG8_WAIT_L(8); PG8_BAR; PG8_WAIT_L(0); PG8_MMA(0, 0, At, B0); PG8_BAR; PG8_SCHED;
            PG8_LDB(B1, 1, 1); PG8_STAGE(PG8_SB(1, 0), b3, voffB);
            PG8_BAR; PG8_WAIT_L(0); PG8_MMA(0, 1, At, B1); PG8_BAR;
            PG8_LDA(At, 1, 1); PG8_STAGE(PG8_SA(1, 0), a3, voffA);
            PG8_BAR; PG8_WAIT_L(0); PG8_MMA(1, 0, At, B0); PG8_BAR; PG8_SCHED;
            PG8_STAGE(PG8_SB(1, 1), b3 + hstep, voffB);
            PG8_WAIT_V(6); PG8_BAR; PG8_MMA(1, 1, At, B1); PG8_BAR;
            }
        }
        if constexpr (ALIGN_EPI) { if (wr == 0) PG8_BAR; }
        if constexpr (!Epi::AFTER_DRAIN) { E(acc, cur, wr, wc, fr, fq); S.done(cur); }
        if (!has_next) break;
#pragma unroll
        for (int a = 0; a < 2; ++a)
#pragma unroll
            for (int b = 0; b < 2; ++b)
#pragma unroll
                for (int m = 0; m < 4; ++m)
#pragma unroll
                    for (int n = 0; n < 2; ++n) acc[a][b][m][n] = (f32x4){0.f, 0.f, 0.f, 0.f};
        cur = nxt; cA = nA; cB = nB; ++ui;
        if constexpr (ALIGN_EPI) { if (wr == 1) PG8_BAR; }
    }
    PG8_WAIT_V(0);
    if constexpr (!ALIGN_EPI) { if (wr == 0) PG8_BAR; }
    PG8_BAR;
    if constexpr (Epi::AFTER_DRAIN) { E.fused(acc, cur, wr, wc, fr, fq, lds, wid, lane); S.done(cur); }
#undef PG8_SA
#undef PG8_SB
#undef PG8_STAGE
#undef PG8_LDA
#undef PG8_LDB
#undef PG8_MMA
#undef PG8_WAIT_V
#undef PG8_WAIT_L
#undef PG8_BAR
#undef PG8_SCHED
}
}

constexpr int NWAVES = 8;
constexpr int BATCH = 2, SEQ = 8192, DM = 1024, M = BATCH * SEQ;
constexpr int IN_W = 5376, DFF = 2816, MEMLEN = 256;
constexpr int PQ_LD = 1792;
constexpr float RMS_EPS = 1e-6f;
constexpr float SB_STOP = -110.0f;

constexpr size_t MiB = 1u << 20;
constexpr size_t WS_SS = 0;
constexpr size_t WS_MK = 1 * MiB, WS_MVT = WS_MK + 256 * 1024, WS_MEMN = WS_MK + 512 * 1024;
constexpr size_t WS_WIN = 3 * MiB, WS_WFI = 14 * MiB, WS_WFO = 25 * MiB, WS_WO = 31 * MiB, WS_WSO = 33 * MiB, WS_WXO = 34 * MiB, WS_WEFF = 35 * MiB, WS_WMK = 36 * MiB;
constexpr size_t WS_XN = 40 * MiB;
constexpr size_t WS_MIXED = 40 * MiB, WS_SBO = 56 * MiB, WS_XO = 72 * MiB;
constexpr size_t WS_GATES = 80 * MiB;
constexpr size_t WS_PQ = 176 * MiB, WS_VT = 232 * MiB;
constexpr size_t WS_MERGED = 176 * MiB, WS_PART = 208 * MiB;
constexpr size_t WS_ACT = 80 * MiB;
constexpr size_t WS_FF = 168 * MiB;
constexpr size_t WS_END = 248 * MiB;
constexpr int LDS_BYTES = 135168;

#define LAS __attribute__((address_space(3)))
typedef unsigned short bf16;
typedef unsigned v4u __attribute__((ext_vector_type(4)));
typedef unsigned v2u __attribute__((ext_vector_type(2)));
typedef float f32x4 __attribute__((ext_vector_type(4)));
typedef float f32x16 __attribute__((ext_vector_type(16)));
typedef short bf16x8 __attribute__((ext_vector_type(8)));
typedef short s16x4 __attribute__((ext_vector_type(4)));
using pg8::pk_bf16; using pg8::bf_lo; using pg8::bf_hi;
#define MFMA32(a, b, c) __builtin_amdgcn_mfma_f32_32x32x16_bf16((a), (b), (c), 0, 0, 0)

__device__ __forceinline__ float wave_sum(float v) {
#pragma unroll
    for (int o = 1; o < 64; o <<= 1) v += __shfl_xor(v, o);
    return v;
}
__device__ __forceinline__ int crow(int r, int hi) { return (r & 3) + 8 * (r >> 2) + 4 * hi; }

struct Args { const float* in[17]; float* out; unsigned char* ws; };
__device__ __forceinline__ int fresh_tid() { int t = threadIdx.x; asm volatile("" : "+v"(t)); return t; }
__device__ __forceinline__ unsigned char* fresh_ptr(unsigned char* p) { asm volatile("" : "+s"(p)); return p; }
enum { I_X = 0, I_MEM, I_NMIXPRE, I_WIN, I_WPMIX, I_PSCALE, I_WPO, I_WSBO, I_NMEM, I_WMEMKV, I_WXO, I_WOUT, I_NMIXPOST, I_NFFNPRE, I_WFFNIN, I_WFFNOUT, I_NFFNPOST };

__device__ __forceinline__ void p0_transpose_item(const float* W, int K, int N, bf16* WT, int dst_row, LAS float* scr, int k0, int n0, int lane) {
#pragma unroll 8
    for (int i = 0; i < 32; ++i) { const int kk = 2 * i + (lane >> 5); scr[kk * 33 + (lane & 31)] = W[(size_t)(k0 + kk) * N + n0 + (lane & 31)]; }
    asm volatile("s_waitcnt lgkmcnt(0)" ::: "memory");
    const int c = lane & 7;
#pragma unroll
    for (int j = 0; j < 4; ++j) { const int n = (lane >> 3) + 8 * j; const LAS float* s = scr + (8 * c) * 33 + n;
        v4u o; o.x = pk_bf16(s[0 * 33], s[1 * 33]); o.y = pk_bf16(s[2 * 33], s[3 * 33]); o.z = pk_bf16(s[4 * 33], s[5 * 33]); o.w = pk_bf16(s[6 * 33], s[7 * 33]);
        *(v4u*)(WT + (size_t)(dst_row + n) * K + k0 + 8 * c) = o; }
    asm volatile("s_waitcnt lgkmcnt(0)" ::: "memory");
}
__device__ __forceinline__ void p0_tr(const float* W, int K, int N, bf16* WT, LAS float* scr, int item, int lane) {
    const int nblk = N / 32, kb = item / nblk, nb = item % nblk;
    p0_transpose_item(W, K, N, WT, 32 * nb, scr, 64 * kb, 32 * nb, lane);
}
__device__ __forceinline__ void rms_row_to_bf16(const float* xrow, const float* g, bf16* orow, int lane) {
    const f32x4* xr = (const f32x4*)xrow + lane; const f32x4* gr = (const f32x4*)g + lane;
    f32x4 v[4]; float s = 0.f;
#pragma unroll
    for (int j = 0; j < 4; ++j) { v[j] = xr[64 * j]; s += (v[j].x * v[j].x + v[j].y * v[j].y) + (v[j].z * v[j].z + v[j].w * v[j].w); }
    const float rstd = rsqrtf(wave_sum(s) * (1.f / DM) + RMS_EPS);
    v2u* o8 = (v2u*)orow + lane;
#pragma unroll
    for (int j = 0; j < 4; ++j) { const f32x4 gg = gr[64 * j]; v2u w; w.x = pk_bf16(v[j].x * rstd * gg.x, v[j].y * rstd * gg.y); w.y = pk_bf16(v[j].z * rstd * gg.z, v[j].w * rstd * gg.w); o8[64 * j] = w; }
}

__device__ __forceinline__ void sb_unit(const bf16* PQ, const bf16* VT, bf16* SBO, int b, int h, int qb, int lane) {
    const int r32 = lane & 31, hi = lane >> 5;
    const size_t rowbase = (size_t)b * SEQ; const int q0 = qb * 32;
    bf16x8 qf[4];
    { const bf16* qp = PQ + (rowbase + q0 + r32) * PQ_LD + 512 + h * 64 + hi * 8;
#pragma unroll
      for (int d0 = 0; d0 < 4; ++d0) qf[d0] = *(const bf16x8*)(qp + d0 * 16); }
    f32x16 o0, o1;
#pragma unroll
    for (int r = 0; r < 16; ++r) { o0[r] = 0.f; o1[r] = 0.f; }
    float R = 0.f;
    const bf16* kbase = PQ + rowbase * PQ_LD + 1024 + h * 64 + hi * 8;
    const bf16* vbase = VT + ((size_t)((b * 8 + h) * 64 + r32)) * SEQ + 4 * hi;
    for (int k0 = q0; k0 >= 0; k0 -= 32) {
        const bf16* kp = kbase + (size_t)(k0 + r32) * PQ_LD;
        bf16x8 kf[4];
#pragma unroll
        for (int d0 = 0; d0 < 4; ++d0) kf[d0] = *(const bf16x8*)(kp + d0 * 16);
        s16x4 vlo[2][2], vhi[2][2];
#pragma unroll
        for (int db = 0; db < 2; ++db)
#pragma unroll
            for (int s = 0; s < 2; ++s) { const bf16* vp = vbase + (size_t)db * 32 * SEQ + k0 + 16 * s; vlo[db][s] = *(const s16x4*)vp; vhi[db][s] = *(const s16x4*)(vp + 8); }
        f32x16 p;
#pragma unroll
        for (int r = 0; r < 16; ++r) p[r] = 0.f;
#pragma unroll
        for (int d0 = 0; d0 < 4; ++d0) p = MFMA32(kf[d0], qf[d0], p);
        const bool diag = (k0 == q0);
        float l[16];
#pragma unroll
        for (int r = 0; r < 16; ++r) {
            const float z = p[r] * 0.125f; p[r] = z;
            const bool valid = !diag || (crow(r, hi) < r32);
            const float sp = fmaxf(z, 0.f) + __logf(1.0f + __expf(-fabsf(z)));
            l[r] = valid ? -sp : 0.f;
        }
        float sc[4], sq[4];
#pragma unroll
        for (int c = 0; c < 4; ++c) { sc[c] = (l[4 * c] + l[4 * c + 1]) + (l[4 * c + 2] + l[4 * c + 3]); sq[c] = __shfl_xor(sc[c], 32); }
        const float T0 = sc[0] + sq[0], T1 = sc[1] + sq[1], T2 = sc[2] + sq[2], T3 = sc[3] + sq[3];
        float U[4]; U[3] = 0.f; U[2] = T3; U[1] = T3 + T2; U[0] = U[1] + T1;
        const float tot = U[0] + T0;
        float a[16];
#pragma unroll
        for (int c = 0; c < 4; ++c) {
            const float base = R + U[c] + (hi == 0 ? sq[c] : 0.f);
            const float i3 = base + l[4 * c + 3], i2 = i3 + l[4 * c + 2], i1 = i2 + l[4 * c + 1], i0 = i1 + l[4 * c];
            a[4 * c + 3] = __expf(p[4 * c + 3] + i3); a[4 * c + 2] = __expf(p[4 * c + 2] + i2); a[4 * c + 1] = __expf(p[4 * c + 1] + i1); a[4 * c] = __expf(p[4 * c] + i0);
        }
        if (diag) {
#pragma unroll
            for (int r = 0; r < 16; ++r) a[r] = (crow(r, hi) < r32) ? a[r] : 0.f;
        }
        R += tot;
#pragma unroll
        for (int s = 0; s < 2; ++s) {
            v4u pw; pw.x = pk_bf16(a[8 * s], a[8 * s + 1]); pw.y = pk_bf16(a[8 * s + 2], a[8 * s + 3]); pw.z = pk_bf16(a[8 * s + 4], a[8 * s + 5]); pw.w = pk_bf16(a[8 * s + 6], a[8 * s + 7]);
            const bf16x8 pf = __builtin_bit_cast(bf16x8, pw);
            const bf16x8 v0 = (bf16x8){vlo[0][s][0], vlo[0][s][1], vlo[0][s][2], vlo[0][s][3], vhi[0][s][0], vhi[0][s][1], vhi[0][s][2], vhi[0][s][3]};
            const bf16x8 v1 = (bf16x8){vlo[1][s][0], vlo[1][s][1], vlo[1][s][2], vlo[1][s][3], vhi[1][s][0], vhi[1][s][1], vhi[1][s][2], vhi[1][s][3]};
            o0 = MFMA32(v0, pf, o0); o1 = MFMA32(v1, pf, o1);
        }
        if (__all(R < SB_STOP)) break;
    }
    bf16* op = SBO + (rowbase + q0 + r32) * 512 + h * 64 + 4 * hi;
#pragma unroll
    for (int g4 = 0; g4 < 4; ++g4) {
        v2u w0; w0.x = pk_bf16(o0[4 * g4], o0[4 * g4 + 1]); w0.y = pk_bf16(o0[4 * g4 + 2], o0[4 * g4 + 3]); *(v2u*)(op + 8 * g4) = w0;
        v2u w1; w1.x = pk_bf16(o1[4 * g4], o1[4 * g4 + 1]); w1.y = pk_bf16(o1[4 * g4 + 2], o1[4 * g4 + 3]); *(v2u*)(op + 32 + 8 * g4) = w1;
    }
}
__device__ __forceinline__ void xattn_unit(const bf16* PQ, const bf16* MK, const bf16* MVT, bf16* XO, int b, int h, int qb, int lane) {
    const int r32 = lane & 31, hi = lane >> 5;
    const size_t row = (size_t)b * SEQ + qb * 32 + r32;
    bf16x8 qf[4];
    { const bf16* qp = PQ + row * PQ_LD + 1536 + h * 64 + hi * 8;
#pragma unroll
      for (int d0 = 0; d0 < 4; ++d0) qf[d0] = *(const bf16x8*)(qp + d0 * 16); }
    f32x16 o0, o1;
#pragma unroll
    for (int r = 0; r < 16; ++r) { o0[r] = 0.f; o1[r] = 0.f; }
    float mrun = -INFINITY, lrun = 0.f;
    const bf16* kbase = MK + (size_t)b * MEMLEN * 256 + h * 64 + hi * 8;
    const bf16* vbase = MVT + ((size_t)((b * 4 + h) * 64 + r32)) * MEMLEN + 4 * hi;
    for (int k0 = 0; k0 < MEMLEN; k0 += 32) {
        const bf16* kp = kbase + (size_t)(k0 + r32) * 256;
        bf16x8 kf[4];
#pragma unroll
        for (int d0 = 0; d0 < 4; ++d0) kf[d0] = *(const bf16x8*)(kp + d0 * 16);
        s16x4 vlo[2][2], vhi[2][2];
#pragma unroll
        for (int db = 0; db < 2; ++db)
#pragma unroll
            for (int s = 0; s < 2; ++s) { const bf16* vp = vbase + (size_t)db * 32 * MEMLEN + k0 + 16 * s; vlo[db][s] = *(const s16x4*)vp; vhi[db][s] = *(const s16x4*)(vp + 8); }
        f32x16 p;
#pragma unroll
        for (int r = 0; r < 16; ++r) p[r] = 0.f;
#pragma unroll
        for (int d0 = 0; d0 < 4; ++d0) p = MFMA32(kf[d0], qf[d0], p);
        float tmax = -INFINITY;
#pragma unroll
        for (int r = 0; r < 16; ++r) { p[r] *= 0.125f; tmax = fmaxf(tmax, p[r]); }
        tmax = fmaxf(tmax, __shfl_xor(tmax, 32));
        const float mnew = fmaxf(mrun, tmax), alpha = __expf(mrun - mnew);
        mrun = mnew; lrun *= alpha;
#pragma unroll
        for (int r = 0; r < 16; ++r) { o0[r] *= alpha; o1[r] *= alpha; }
        float a[16];
#pragma unroll
        for (int r = 0; r < 16; ++r) { a[r] = __expf(p[r] - mnew); lrun += a[r]; }
#pragma unroll
        for (int s = 0; s < 2; ++s) {
            v4u pw; pw.x = pk_bf16(a[8 * s], a[8 * s + 1]); pw.y = pk_bf16(a[8 * s + 2], a[8 * s + 3]); pw.z = pk_bf16(a[8 * s + 4], a[8 * s + 5]); pw.w = pk_bf16(a[8 * s + 6], a[8 * s + 7]);
            const bf16x8 pf = __builtin_bit_cast(bf16x8, pw);
            const bf16x8 v0 = (bf16x8){vlo[0][s][0], vlo[0][s][1], vlo[0][s][2], vlo[0][s][3], vhi[0][s][0], vhi[0][s][1], vhi[0][s][2], vhi[0][s][3]};
            const bf16x8 v1 = (bf16x8){vlo[1][s][0], vlo[1][s][1], vlo[1][s][2], vlo[1][s][3], vhi[1][s][0], vhi[1][s][1], vhi[1][s][2], vhi[1][s][3]};
            o0 = MFMA32(v0, pf, o0); o1 = MFMA32(v1, pf, o1);
        }
    }
    const float inv = 1.0f / (lrun + __shfl_xor(lrun, 32));
    bf16* op = XO + row * 256 + h * 64 + 4 * hi;
#pragma unroll
    for (int g4 = 0; g4 < 4; ++g4) {
        v2u w0; w0.x = pk_bf16(o0[4 * g4] * inv, o0[4 * g4 + 1] * inv); w0.y = pk_bf16(o0[4 * g4 + 2] * inv, o0[4 * g4 + 3] * inv); *(v2u*)(op + 8 * g4) = w0;
        v2u w1; w1.x = pk_bf16(o1[4 * g4] * inv, o1[4 * g4 + 1] * inv); w1.y = pk_bf16(o1[4 * g4 + 2] * inv, o1[4 * g4 + 3] * inv); *(v2u*)(op + 32 + 8 * g4) = w1;
    }
}
__device__ __forceinline__ void pool_token(const bf16* PQ, bf16* MIXED, int row, int lane) {
    const int pos = row & (SEQ - 1), g = lane >> 4, w = 2 << g;
    const int cnt = (pos + 1 < w) ? pos + 1 : w;
    const bf16* p = PQ + (size_t)row * PQ_LD + lane * 8;
    float s[8];
#pragma unroll
    for (int j = 0; j < 8; ++j) s[j] = 0.f;
    const v4u self = *(const v4u*)p;
    for (int i = 0; i < cnt; ++i) { const v4u v = *(const v4u*)(p - (size_t)i * PQ_LD);
        s[0] += bf_lo(v.x); s[1] += bf_hi(v.x); s[2] += bf_lo(v.y); s[3] += bf_hi(v.y); s[4] += bf_lo(v.z); s[5] += bf_hi(v.z); s[6] += bf_lo(v.w); s[7] += bf_hi(v.w); }
    const float ic = 1.0f / (float)cnt;
    v4u o;
    o.x = pk_bf16(s[0] * ic - bf_lo(self.x), s[1] * ic - bf_hi(self.x)); o.y = pk_bf16(s[2] * ic - bf_lo(self.y), s[3] * ic - bf_hi(self.y));
    o.z = pk_bf16(s[4] * ic - bf_lo(self.z), s[5] * ic - bf_hi(self.z)); o.w = pk_bf16(s[6] * ic - bf_lo(self.w), s[7] * ic - bf_hi(self.w));
    *(v4u*)(MIXED + (size_t)row * 512 + lane * 8) = o;
}

__global__ void __launch_bounds__(NWAVES * 64, 2) fwd_megakernel(Args args) {
    extern __shared__ __attribute__((aligned(16))) unsigned char lds_raw[];
    cg::grid_group grid = cg::this_grid();
    LAS unsigned char* lds = (LAS unsigned char*)lds_raw;
    const int G = gridDim.x, bx = blockIdx.x;
#define PHASE_VARS() const int tid_ = fresh_tid(), lane = tid_ & 63, wave = __builtin_amdgcn_readfirstlane(tid_ >> 6); const int gw = bx * NWAVES + wave, NGW = G * NWAVES; unsigned char* ws = fresh_ptr(args.ws); (void)lane; (void)gw; (void)NGW; (void)ws
#define WSP(T, off) ((T*)(ws + (off)))

    {
        PHASE_VARS();
        bf16* WIN_T = WSP(bf16, WS_WIN); bf16* WFI_T = WSP(bf16, WS_WFI); bf16* WFO_T = WSP(bf16, WS_WFO); bf16* WO_T = WSP(bf16, WS_WO);
        bf16* WSO_T = WSP(bf16, WS_WSO); bf16* WXO_T = WSP(bf16, WS_WXO); bf16* WEFF_T = WSP(bf16, WS_WEFF); bf16* WMK_T = WSP(bf16, WS_WMK);
        bf16* XN = WSP(bf16, WS_XN); bf16* MEMN = WSP(bf16, WS_MEMN);
        LAS float* scr = (LAS float*)(lds + wave * 16384);
        constexpr int I_IN = 16 * 168, I_FI = 16 * 176, I_FO = 44 * 32, I_O = 16 * 32, I_SO = 8 * 32, I_XO = 4 * 32, I_MK = 16 * 16, I_EFF = 1024;
        constexpr int NIT = I_IN + I_FI + I_FO + I_O + I_SO + I_XO + I_MK + I_EFF;
        for (int it = gw; it < NIT; it += NGW) {
            int r = it;
            if (r < I_IN) { p0_tr(args.in[I_WIN], 1024, IN_W, WIN_T, scr, r, lane); continue; } r -= I_IN;
            if (r < I_FI) {
                const int nblk = (2 * DFF) / 32, kb = r / nblk, nb = r % nblk, n0 = 32 * nb; const int up = n0 >= DFF ? 1 : 0, j = n0 - up * DFF;
                p0_transpose_item(args.in[I_WFFNIN], 1024, 2 * DFF, WFI_T, 256 * (j >> 7) + 128 * up + (j & 127), scr, 64 * kb, n0, lane); continue; } r -= I_FI;
            if (r < I_FO) { p0_tr(args.in[I_WFFNOUT], DFF, 1024, WFO_T, scr, r, lane); continue; } r -= I_FO;
            if (r < I_O) { p0_tr(args.in[I_WOUT], 1024, 1024, WO_T, scr, r, lane); continue; } r -= I_O;
            if (r < I_SO) { p0_tr(args.in[I_WSBO], 512, 1024, WSO_T, scr, r, lane); continue; } r -= I_SO;
            if (r < I_XO) { p0_tr(args.in[I_WXO], 256, 1024, WXO_T, scr, r, lane); continue; } r -= I_XO;
            if (r < I_MK) { p0_tr(args.in[I_WMEMKV], 1024, 512, WMK_T, scr, r, lane); continue; } r -= I_MK;
            {
                const int gc0 = (r >> 4) * 8, g = gc0 >> 7, n = (r & 15) * 64 + lane;
                const float* wm = args.in[I_WPMIX] + (size_t)gc0 * 128;
                const float* sc = args.in[I_PSCALE] + g * 128; const float* wpo = args.in[I_WPO] + (size_t)g * 128 * 1024 + n;
                float acc[8];
#pragma unroll
                for (int j = 0; j < 8; ++j) acc[j] = 0.f;
                for (int d = 0; d < 128; ++d) { const float w = wpo[(size_t)d * 1024] * sc[d];
#pragma unroll
                    for (int j = 0; j < 8; ++j) acc[j] += wm[j * 128 + d] * w; }
                v4u o; o.x = pk_bf16(acc[0], acc[1]); o.y = pk_bf16(acc[2], acc[3]); o.z = pk_bf16(acc[4], acc[5]); o.w = pk_bf16(acc[6], acc[7]);
                *(v4u*)(WEFF_T + (size_t)n * 512 + gc0) = o;
            }
        }
        for (int m = gw; m < M; m += NGW) rms_row_to_bf16(args.in[I_X] + (size_t)m * DM, args.in[I_NMIXPRE], XN + (size_t)m * DM, lane);
        for (int m = gw; m < BATCH * MEMLEN; m += NGW) rms_row_to_bf16(args.in[I_MEM] + (size_t)m * DM, args.in[I_NMEM], MEMN + (size_t)m * DM, lane);
    }
    grid.sync();

    {
        PHASE_VARS();
        pg8::EpiProj E{WSP(bf16, WS_PQ), WSP(bf16, WS_GATES), WSP(bf16, WS_VT), WSP(bf16, WS_MK), WSP(bf16, WS_MVT), 0};
        { pg8::Gemm g{WSP(bf16, WS_XN), WSP(bf16, WS_WIN), M, IN_W, 1024}; pg8::StaticOrder S; S.init(M, IN_W, G, bx);
          pg8::gemm_phase<pg8::EpiProj, pg8::StaticOrder, true, true>(lds, g, S, E); }
        E.kind = 1;
        { pg8::Gemm g{WSP(bf16, WS_MEMN), WSP(bf16, WS_WMK), BATCH * MEMLEN, 512, 1024}; pg8::StaticOrder S; S.init(BATCH * MEMLEN, 512, G, (bx + G - (64 % G)) % G);
          pg8::gemm_phase<pg8::EpiProj, pg8::StaticOrder, true, true>(lds, g, S, E); }
    }
    grid.sync();

    {
        PHASE_VARS();
        const bf16* PQ = WSP(bf16, WS_PQ);
        for (int u = gw; u < 16 * 256; u += NGW) { const int bh = u >> 8, qb = u & 255; sb_unit(PQ, WSP(bf16, WS_VT), WSP(bf16, WS_SBO), bh >> 3, bh & 7, qb, lane); }
        for (int u = gw; u < 8 * 256; u += NGW) { const int bh = u >> 8, qb = u & 255; xattn_unit(PQ, WSP(bf16, WS_MK), WSP(bf16, WS_MVT), WSP(bf16, WS_XO), bh >> 2, bh & 3, qb, lane); }
        for (int r = gw; r < M; r += NGW) pool_token(PQ, WSP(bf16, WS_MIXED), r, lane);
    }
    grid.sync();

    {
        PHASE_VARS();
        for (int br = 0; br < 3; ++br) {
            const bf16* A = br == 0 ? WSP(bf16, WS_MIXED) : (br == 1 ? WSP(bf16, WS_SBO) : WSP(bf16, WS_XO)); const bf16* Bt = br == 0 ? WSP(bf16, WS_WEFF) : (br == 1 ? WSP(bf16, WS_WSO) : WSP(bf16, WS_WXO)); const int K = br == 2 ? 256 : 512;
            pg8::Gemm g{A, Bt, M, DM, K}; pg8::StaticOrder S; S.init(M, DM, G, bx);
            pg8::EpiGate E{WSP(bf16, WS_GATES) + br * 1024, br == 0 ? (const bf16*)nullptr : WSP(bf16, WS_PART), br == 2 ? WSP(bf16, WS_MERGED) : WSP(bf16, WS_PART)};
            pg8::gemm_phase<pg8::EpiGate, pg8::StaticOrder, true, true>(lds, g, S, E);
        }
    }
    grid.sync();

    {
        PHASE_VARS();
        pg8::Gemm g{WSP(bf16, WS_MERGED), WSP(bf16, WS_WO), M, DM, 1024}; pg8::StaticOrder S; S.init(M, DM, G, bx);
        pg8::EpiF32SS E{args.out, WSP(float, WS_SS)};
        pg8::gemm_phase<pg8::EpiF32SS, pg8::StaticOrder, true, true>(lds, g, S, E);
    }
    grid.sync();

    {
        PHASE_VARS();
        const float* SS = WSP(float, WS_SS); bf16* XN = WSP(bf16, WS_XN); float* out = args.out; const float* x = args.in[I_X];
        for (int m = gw; m < M; m += NGW) {
            const float ssv = lane < 16 ? SS[(size_t)m * 16 + lane] : 0.f;
            const float rstd = rsqrtf(wave_sum(ssv) * (1.f / DM) + RMS_EPS);
            f32x4* ur = (f32x4*)(out + (size_t)m * DM) + lane; const f32x4* xr = (const f32x4*)(x + (size_t)m * DM) + lane;
            const f32x4* gp = (const f32x4*)args.in[I_NMIXPOST] + lane; const f32x4* gf = (const f32x4*)args.in[I_NFFNPRE] + lane;
            f32x4 hv[4]; float s = 0.f;
#pragma unroll
            for (int j = 0; j < 4; ++j) { const f32x4 uv = ur[64 * j], xv = xr[64 * j], gg = gp[64 * j]; hv[j] = xv + uv * rstd * gg;
                s += (hv[j].x * hv[j].x + hv[j].y * hv[j].y) + (hv[j].z * hv[j].z + hv[j].w * hv[j].w); ur[64 * j] = hv[j]; }
            const float rstd2 = rsqrtf(wave_sum(s) * (1.f / DM) + RMS_EPS);
            v2u* o8 = (v2u*)(XN + (size_t)m * DM) + lane;
#pragma unroll
            for (int j = 0; j < 4; ++j) { const f32x4 gg = gf[64 * j]; v2u w; w.x = pk_bf16(hv[j].x * rstd2 * gg.x, hv[j].y * rstd2 * gg.y); w.y = pk_bf16(hv[j].z * rstd2 * gg.z, hv[j].w * rstd2 * gg.w); o8[64 * j] = w; }
        }
    }
    grid.sync();

    {
        PHASE_VARS();
        pg8::Gemm g{WSP(bf16, WS_XN), WSP(bf16, WS_WFI), M, 2 * DFF, 1024}; pg8::StaticOrder S; S.init(M, 2 * DFF, G, bx);
        pg8::EpiSwiGLU E{WSP(bf16, WS_ACT)};
        pg8::gemm_phase<pg8::EpiSwiGLU, pg8::StaticOrder, true, true>(lds, g, S, E);
    }
    grid.sync();

    {
        PHASE_VARS();
        pg8::Gemm g{WSP(bf16, WS_ACT), WSP(bf16, WS_WFO), M, DM, DFF}; pg8::StaticOrder S; S.init(M, DM, G, bx);
        pg8::EpiF32SS E{WSP(float, WS_FF), WSP(float, WS_SS)};
        pg8::gemm_phase<pg8::EpiF32SS, pg8::StaticOrder, true, true>(lds, g, S, E);
    }
    grid.sync();

    {
        PHASE_VARS();
        const float* SS = WSP(float, WS_SS); const float* FF = WSP(float, WS_FF); float* out = args.out;
        for (int m = gw; m < M; m += NGW) {
            const float ssv = lane < 16 ? SS[(size_t)m * 16 + lane] : 0.f;
            const float rstd = rsqrtf(wave_sum(ssv) * (1.f / DM) + RMS_EPS);
            f32x4* hr = (f32x4*)(out + (size_t)m * DM) + lane; const f32x4* fr = (const f32x4*)(FF + (size_t)m * DM) + lane;
            const f32x4* gp = (const f32x4*)args.in[I_NFFNPOST] + lane;
#pragma unroll
            for (int j = 0; j < 4; ++j) { const f32x4 fv = fr[64 * j], hv = hr[64 * j], gg = gp[64 * j]; hr[64 * j] = hv + fv * rstd * gg; }
        }
    }
}

extern "C" void kernel_launch(void* const* d_in, const int* in_sizes, int n_in, void* d_out, int out_size, void* d_ws, size_t ws_size, hipStream_t stream) {
    static int grid = 0;
    if (grid == 0) {
        if (n_in != 17 || in_sizes[0] != M * DM || out_size != M * DM || ws_size < WS_END) { fprintf(stderr, "kernel_launch: unexpected shapes (n_in %d, in0 %d, out %d, ws %zu); nothing launched\n", n_in, n_in > 0 ? in_sizes[0] : -1, out_size, ws_size); grid = -1; return; }
        int dev = 0, cus = 0, per_cu = 0;
        hipGetDevice(&dev);
        hipDeviceGetAttribute(&cus, hipDeviceAttributeMultiprocessorCount, dev);
        hipFuncSetAttribute((const void*)fwd_megakernel, hipFuncAttributeMaxDynamicSharedMemorySize, LDS_BYTES);
        hipOccupancyMaxActiveBlocksPerMultiprocessor(&per_cu, (const void*)fwd_megakernel, NWAVES * 64, LDS_BYTES);
        if (per_cu < 1) per_cu = 1;
        (void)hipGetLastError();
        grid = cus * per_cu;
    }
    if (grid < 0) return;
    Args a{};
    for (int i = 0; i < 17; ++i) a.in[i] = (const float*)d_in[i];
    a.out = (float*)d_out; a.ws = (unsigned char*)d_ws;
    void* kargs[] = {&a};
    hipError_t e = hipLaunchCooperativeKernel((const void*)fwd_megakernel, dim3(grid), dim3(NWAVES * 64), kargs, LDS_BYTES, stream);
    if (e != hipSuccess) fprintf(stderr, "cooperative launch failed: %s (grid %d)\n", hipGetErrorString(e), grid);
}
```

```cpp
#include <hip/hip_runtime.h>
#include <hip/hip_cooperative_groups.h>
#include <cstdio>
#include <cstdint>
namespace cg = cooperative_groups;
namespace pg8 {
#define PG8_LAS __attribute__((address_space(3)))
typedef unsigned short bf16_t;
typedef short bf16x8 __attribute__((ext_vector_type(8)));
typedef float f32x4 __attribute__((ext_vector_type(4)));
typedef unsigned u32x4 __attribute__((ext_vector_type(4)));
constexpr int BM = 256, BK = 64, HALF = 128, HTB = HALF * BK * 2  , STAGE_BYTES = 8 * HTB, NXCD = 8, WGM = 8;

__host__ __device__ __forceinline__ int lds_byte(int r, int c) { const int st = (r >> 4) * 2 + (c >> 5), rr = r & 15, cc = c & 31, ob = rr * 64 + cc * 2; return st * 1024 + (ob ^ (((ob >> 9) & 1) << 5)); }
__host__ __device__ __forceinline__ void stage_rc(int b, int& R, int& C) { const int st = b / 1024, sb = b % 1024, swz = sb ^ (((sb >> 9) & 1) << 5); R = (st >> 1) * 16 + swz / 64; C = (st & 1) * 32 + (swz % 64) / 2; }
__host__ __device__ __forceinline__ int perm32(int rho) { const int n = rho >> 4, i = rho & 15; return 8 * (i >> 2) + 4 * n + (i & 3); }

struct Unit { int pm, pn; };
struct Gemm { const bf16_t* A; const bf16_t* Bt; int M, N, K; };

struct StaticOrder {
    int nM, nN, nwg, G, c;
    __host__ __device__ void init(int M, int N, int G_, int c_) { nM = M / BM; nN = N / BM; nwg = nM * nN; G = G_; c = c_; }
    __host__ __device__ bool next(int i, Unit& u) const {
        const long L = (long)i * G + c; if (L >= nwg) return false;
        int wgid = (int)L; { const int q = nwg / NXCD, r = nwg % NXCD, xcd = wgid % NXCD, off = wgid / NXCD; wgid = (xcd < r ? xcd * (q + 1) : r * (q + 1) + (xcd - r) * q) + off; }
        const int nig = WGM * nN, gid = wgid / nig, fm = gid * WGM, gsz = (nM - fm) < WGM ? (nM - fm) : WGM;
        u.pm = fm + ((wgid % nig) % gsz); u.pn = (wgid % nig) / gsz; return true;
    }
    __device__ __forceinline__ void a_ready(const Unit&) const {}
    __device__ __forceinline__ void done(const Unit&) const {}
};


typedef float f32x2_t __attribute__((ext_vector_type(2)));
typedef __bf16 bf16x2_t __attribute__((ext_vector_type(2)));
__device__ __forceinline__ unsigned pk_bf16(float lo, float hi) { f32x2_t v = {lo, hi}; bf16x2_t b = __builtin_convertvector(v, bf16x2_t); return __builtin_bit_cast(unsigned, b); }
__device__ __forceinline__ float bf_lo(unsigned u) { return __uint_as_float(u << 16); }
__device__ __forceinline__ float bf_hi(unsigned u) { return __uint_as_float(u & 0xffff0000u); }
__device__ __forceinline__ float sigmoid_f(float x) { return __builtin_amdgcn_rcpf(1.0f + __expf(-x)); }

struct EpiProj {
    static constexpr bool PERM = true, AFTER_DRAIN = false;
    bf16_t* pq; bf16_t* gates; bf16_t* vt; bf16_t* mk; bf16_t* mvt; int kind;
    __device__ __forceinline__ void operator()(const f32x4 (&acc)[2][2][4][2], const Unit& u, int wr, int wc, int fr, int fq) const {
        int mode, ldc = 0, colt = 0, lgS = 0, H = 0; bf16_t* base;
        if (kind == 0) {
            if (u.pn >= 9) { mode = 1; base = gates; ldc = 3072; colt = (u.pn - 9) * 256; }
            else if (u.pn == 6 || u.pn == 7) { mode = 2; base = vt; colt = (u.pn - 6) * 256; lgS = 13; H = 8; }
            else { mode = 0; base = pq; ldc = 1792; colt = (u.pn == 8) ? 1536 : u.pn * 256; }
        } else {
            if (u.pn == 0) { mode = 0; base = mk; ldc = 256; colt = 0; }
            else { mode = 2; base = mvt; colt = 0; lgS = 8; H = 4; }
        }
        const int row0 = u.pm * BM + wr * 64 + fr;
        const int c0 = wc * 32 + 8 * fq;
        if (mode != 2) {
#pragma unroll
            for (int ai = 0; ai < 2; ++ai)
#pragma unroll
                for (int m = 0; m < 4; ++m) { bf16_t* rowp = base + (size_t)(row0 + ai * HALF + m * 16) * ldc + colt + c0;
#pragma unroll
                    for (int bj = 0; bj < 2; ++bj) { f32x4 v0 = acc[ai][bj][m][0], v1 = acc[ai][bj][m][1];
                        if (mode == 1) {
#pragma unroll
                            for (int j = 0; j < 4; ++j) { v0[j] = sigmoid_f(v0[j]); v1[j] = sigmoid_f(v1[j]); } }
                        u32x4 w; w.x = pk_bf16(v0[0], v0[1]); w.y = pk_bf16(v0[2], v0[3]); w.z = pk_bf16(v1[0], v1[1]); w.w = pk_bf16(v1[2], v1[3]);
                        *(u32x4*)(rowp + bj * HALF) = w; } }
        } else {
            const int S = 1 << lgS;
#pragma unroll
            for (int ai = 0; ai < 2; ++ai)
#pragma unroll
                for (int m = 0; m < 4; ++m) { const int row = row0 + ai * HALF + m * 16, b = row >> lgS, t = row & (S - 1);
#pragma unroll
                    for (int bj = 0; bj < 2; ++bj)
#pragma unroll
                        for (int n = 0; n < 2; ++n) { const f32x4 v = acc[ai][bj][m][n];
#pragma unroll
                            for (int j = 0; j < 4; ++j) { const int col = colt + bj * HALF + c0 + 4 * n + j, hh = col >> 6, d = col & 63;
                                const unsigned pk = pk_bf16(v[j], 0.f);
                                base[(((size_t)(b * H + hh) * 64 + d) << lgS) + t] = (bf16_t)(pk & 0xffffu); } } }
        }
    }
};
struct EpiGate {
    static constexpr bool PERM = true, AFTER_DRAIN = false;
    const bf16_t* gates; const bf16_t* pin; bf16_t* pout;
    __device__ __forceinline__ void operator()(const f32x4 (&acc)[2][2][4][2], const Unit& u, int wr, int wc, int fr, int fq) const {
        const int row0 = u.pm * BM + wr * 64 + fr, col0 = u.pn * BM + wc * 32 + 8 * fq;
#pragma unroll
        for (int ai = 0; ai < 2; ++ai)
#pragma unroll
            for (int m = 0; m < 4; ++m) { const size_t row = (size_t)(row0 + ai * HALF + m * 16);
#pragma unroll
                for (int bj = 0; bj < 2; ++bj) { const int col = col0 + bj * HALF;
                    const u32x4 g = *(const u32x4*)(gates + row * 3072 + col);
                    u32x4 p = {0u, 0u, 0u, 0u}; if (pin) p = *(const u32x4*)(pin + row * 1024 + col);
                    const f32x4 v0 = acc[ai][bj][m][0], v1 = acc[ai][bj][m][1];
                    u32x4 w;
                    w.x = pk_bf16(bf_lo(p.x) + bf_lo(g.x) * v0[0], bf_hi(p.x) + bf_hi(g.x) * v0[1]);
                    w.y = pk_bf16(bf_lo(p.y) + bf_lo(g.y) * v0[2], bf_hi(p.y) + bf_hi(g.y) * v0[3]);
                    w.z = pk_bf16(bf_lo(p.z) + bf_lo(g.z) * v1[0], bf_hi(p.z) + bf_hi(g.z) * v1[1]);
                    w.w = pk_bf16(bf_lo(p.w) + bf_lo(g.w) * v1[2], bf_hi(p.w) + bf_hi(g.w) * v1[3]);
                    *(u32x4*)(pout + row * 1024 + col) = w; } }
    }
};
struct EpiSwiGLU {
    static constexpr bool PERM = true, AFTER_DRAIN = false;
    bf16_t* O;
    __device__ __forceinline__ void operator()(const f32x4 (&acc)[2][2][4][2], const Unit& u, int wr, int wc, int fr, int fq) const {
        const int row0 = u.pm * BM + wr * 64 + fr, col0 = u.pn * HALF + wc * 32 + 8 * fq;
#pragma unroll
        for (int ai = 0; ai < 2; ++ai)
#pragma unroll
            for (int m = 0; m < 4; ++m) { const size_t row = (size_t)(row0 + ai * HALF + m * 16);
                float o[8];
#pragma unroll
                for (int n = 0; n < 2; ++n)
#pragma unroll
                    for (int j = 0; j < 4; ++j) { const float g = acc[ai][0][m][n][j], up = acc[ai][1][m][n][j]; o[4 * n + j] = g * sigmoid_f(g) * up; }
                u32x4 w; w.x = pk_bf16(o[0], o[1]); w.y = pk_bf16(o[2], o[3]); w.z = pk_bf16(o[4], o[5]); w.w = pk_bf16(o[6], o[7]);
                *(u32x4*)(O + row * 2816 + col0) = w; }
    }
};
struct EpiF32SS {
    static constexpr bool PERM = false, AFTER_DRAIN = false;
    float* O; float* SS;
    __device__ __forceinline__ void operator()(const f32x4 (&acc)[2][2][4][2], const Unit& u, int wr, int wc, int fr, int fq) const {
        const int row0 = u.pm * BM + wr * 64 + fr, col0 = u.pn * BM + wc * 32 + 4 * fq;
#pragma unroll
        for (int ai = 0; ai < 2; ++ai)
#pragma unroll
            for (int m = 0; m < 4; ++m) { const size_t row = (size_t)(row0 + ai * HALF + m * 16); float s = 0.f;
#pragma unroll
                for (int bj = 0; bj < 2; ++bj)
#pragma unroll
                    for (int n = 0; n < 2; ++n) { const f32x4 v = acc[ai][bj][m][n]; s += (v[0] * v[0] + v[1] * v[1]) + (v[2] * v[2] + v[3] * v[3]);
                        *(f32x4*)(O + row * 1024 + col0 + bj * HALF + n * 16) = v; }
                s += __shfl_xor(s, 16); s += __shfl_xor(s, 32);
                if (fq == 0) SS[row * 16 + u.pn * 4 + wc] = s; }
    }
};

template <class Epi, class Sched, bool ALIGN_EPI = false, bool SP2 = false>
__device__ __forceinline__ void gemm_phase(PG8_LAS unsigned char* lds, const Gemm g, const Sched& S, const Epi& E) {
    int tid_raw = threadIdx.x; asm volatile("" : "+v"(tid_raw));
    const int tid = tid_raw, wid = __builtin_amdgcn_readfirstlane(tid >> 6), lane = tid & 63, wr = wid >> 2, wc = wid & 3, fr = lane & 15, fq = lane >> 4;
    const int K = g.K, nt = K / BK;
    unsigned voffA[2], voffB[2];
#pragma unroll
    for (int i = 0; i < 2; ++i) { int R, C; stage_rc(tid * 16 + i * 8192, R, C); const int Rb = Epi::PERM ? ((R & ~31) + perm32(R & 31)) : R;
        voffA[i] = (unsigned)(R * K + C) * 2u; voffB[i] = (unsigned)(Rb * K + C) * 2u; }
    const size_t kstep = (size_t)(BK * 2);
    const size_t hstep = (size_t)HALF * K * 2;
    const size_t tstep = 2 * hstep;
    const unsigned ldsw = (unsigned)wid * 1024u;
    const int aoff = lds_byte(wr * 64 + fr, fq * 8), boff = lds_byte(wc * 32 + fr, fq * 8);
#define PG8_SA(b, h) (((b) * 2 + (h)) * HTB)
#define PG8_SB(b, h) ((4 + (b) * 2 + (h)) * HTB)
#define PG8_STAGE(bufoff, gbase, voff) do { _Pragma("unroll") for (int _i = 0; _i < 2; ++_i) \
        __builtin_amdgcn_global_load_lds((const unsigned*)((const char*)(gbase) + (voff)[_i]), (PG8_LAS unsigned*)(lds + (bufoff) + ldsw + _i * 8192), 16, 0, 0); } while (0)
#define PG8_LDA(dst, b, h) do { _Pragma("unroll") for (int m = 0; m < 4; ++m) _Pragma("unroll") for (int k = 0; k < 2; ++k) dst[m][k] = *(const PG8_LAS bf16x8*)(lds + PG8_SA(b, h) + aoff + m * 2048 + k * 1024); } while (0)
#define PG8_LDB(dst, b, h) do { _Pragma("unroll") for (int n = 0; n < 2; ++n) _Pragma("unroll") for (int k = 0; k < 2; ++k) dst[n][k] = *(const PG8_LAS bf16x8*)(lds + PG8_SB(b, h) + boff + n * 2048 + k * 1024); } while (0)
#define PG8_MMA(ai, bj, At, Bt) do { __builtin_amdgcn_s_setprio(1); _Pragma("unroll") for (int m = 0; m < 4; ++m) _Pragma("unroll") for (int n = 0; n < 2; ++n) _Pragma("unroll") for (int k = 0; k < 2; ++k) \
        acc[ai][bj][m][n] = __builtin_amdgcn_mfma_f32_16x16x32_bf16(Bt[n][k], At[m][k], acc[ai][bj][m][n], 0, 0, 0); __builtin_amdgcn_s_setprio(0); } while (0)
#define PG8_WAIT_V(n) asm volatile("s_waitcnt vmcnt(" #n ")" ::: "memory")
#define PG8_WAIT_L(n) asm volatile("s_waitcnt lgkmcnt(" #n ")" ::: "memory")
#define PG8_BAR __builtin_amdgcn_s_barrier()
#define PG8_SCHED __builtin_amdgcn_sched_barrier(0)
    Unit cur, nxt; int ui = 0;
    if (!S.next(0, cur)) return;
    f32x4 acc[2][2][4][2];
#pragma unroll
    for (int a = 0; a < 2; ++a)
#pragma unroll
        for (int b = 0; b < 2; ++b)
#pragma unroll
            for (int m = 0; m < 4; ++m)
#pragma unroll
                for (int n = 0; n < 2; ++n) acc[a][b][m][n] = (f32x4){0.f, 0.f, 0.f, 0.f};
    bf16x8 At[4][2], B0[2][2], B1[2][2];
    const char* cA = (const char*)g.A + (size_t)cur.pm * tstep; const char* cB = (const char*)g.Bt + (size_t)cur.pn * tstep;
    S.a_ready(cur);
    if constexpr (SP2) {
        PG8_STAGE(PG8_SB(0, 0), cB, voffB); PG8_STAGE(PG8_SB(0, 1), cB + hstep, voffB); PG8_STAGE(PG8_SA(0, 0), cA, voffA); PG8_STAGE(PG8_SA(0, 1), cA + hstep, voffA);
        if (wr == 1) PG8_BAR;
        PG8_WAIT_V(2); PG8_BAR;
        PG8_STAGE(PG8_SB(1, 0), cB + kstep, voffB); PG8_STAGE(PG8_SA(1, 0), cA + kstep, voffA); PG8_STAGE(PG8_SB(1, 1), cB + hstep + kstep, voffB);
        PG8_WAIT_V(6); PG8_BAR;
    } else {
        PG8_STAGE(PG8_SB(0, 0), cB, voffB); PG8_STAGE(PG8_SA(0, 0), cA, voffA); PG8_STAGE(PG8_SB(0, 1), cB + hstep, voffB); PG8_STAGE(PG8_SA(0, 1), cA + hstep, voffA);
        if (wr == 1) PG8_BAR;
        PG8_WAIT_V(4); PG8_BAR;
        PG8_STAGE(PG8_SB(1, 0), cB + kstep, voffB); PG8_STAGE(PG8_SA(1, 0), cA + kstep, voffA); PG8_STAGE(PG8_SB(1, 1), cB + hstep + kstep, voffB);
        PG8_WAIT_V(6); PG8_BAR;
    }
    for (;;) {
        const bool has_next = S.next(ui + 1, nxt);
        const char* nA = has_next ? (const char*)g.A + (size_t)nxt.pm * tstep : cA; const char* nB = has_next ? (const char*)g.Bt + (size_t)nxt.pn * tstep : cB;
        for (int t = 0; t < nt; t += 2) {
            const bool last = (t == nt - 2);
            const char* a1 = cA + (size_t)(t + 1) * kstep;
            const char* a2 = last ? nA : cA + (size_t)(t + 2) * kstep; const char* b2 = last ? nB : cB + (size_t)(t + 2) * kstep;
            const char* a3 = a2 + kstep; const char* b3 = b2 + kstep;
            if (last && has_next) S.a_ready(nxt);
            if constexpr (SP2) {
            PG8_LDB(B0, 0, 0); PG8_LDB(B1, 0, 1); PG8_SCHED; PG8_LDA(At, 0, 0); PG8_STAGE(PG8_SA(1, 1), a1 + hstep, voffA);
            PG8_WAIT_V(8); PG8_WAIT_L(0); PG8_BAR; PG8_MMA(0, 0, At, B0); PG8_MMA(0, 1, At, B1); PG8_BAR; PG8_SCHED;
            PG8_LDA(At, 0, 1); PG8_STAGE(PG8_SB(0, 0), b2, voffB); PG8_STAGE(PG8_SB(0, 1), b2 + hstep, voffB); PG8_STAGE(PG8_SA(0, 0), a2, voffA);
            PG8_WAIT_V(8); PG8_WAIT_L(0); PG8_BAR; PG8_MMA(1, 0, At, B0); PG8_MMA(1, 1, At, B1); PG8_BAR; PG8_SCHED;
            PG8_LDB(B0, 1, 0); PG8_LDB(B1, 1, 1); PG8_SCHED; PG8_LDA(At, 1, 0); PG8_STAGE(PG8_SA(0, 1), a2 + hstep, voffA);
            PG8_WAIT_V(8); PG8_WAIT_L(0); PG8_BAR; PG8_MMA(0, 0, At, B0); PG8_MMA(0, 1, At, B1); PG8_BAR; PG8_SCHED;
            PG8_LDA(At, 1, 1); PG8_STAGE(PG8_SB(1, 0), b3, voffB); PG8_STAGE(PG8_SB(1, 1), b3 + hstep, voffB); PG8_STAGE(PG8_SA(1, 0), a3, voffA);
            PG8_WAIT_V(8); PG8_WAIT_L(0); PG8_BAR; PG8_MMA(1, 0, At, B0); PG8_MMA(1, 1, At, B1); PG8_BAR; PG8_SCHED;
            } else {
            PG8_LDB(B0, 0, 0); PG8_SCHED; PG8_LDA(At, 0, 0); PG8_STAGE(PG8_SA(1, 1), a1 + hstep, voffA);
            PG8_WAIT_L(8); PG8_BAR; PG8_WAIT_L(0); PG8_MMA(0, 0, At, B0); PG8_BAR; PG8_SCHED;
            PG8_LDB(B1, 0, 1); PG8_STAGE(PG8_SB(0, 0), b2, voffB);
            PG8_BAR; PG8_WAIT_L(0); PG8_MMA(0, 1, At, B1); PG8_BAR;
            PG8_LDA(At, 0, 1); PG8_STAGE(PG8_SA(0, 0), a2, voffA);
            PG8_BAR; PG8_WAIT_L(0); PG8_MMA(1, 0, At, B0); PG8_BAR; PG8_SCHED;
            PG8_STAGE(PG8_SB(0, 1), b2 + hstep, voffB);
            PG8_WAIT_V(6); PG8_BAR; PG8_MMA(1, 1, At, B1); PG8_BAR;
            PG8_LDB(B0, 1, 0); PG8_SCHED; PG8_LDA(At, 1, 0); PG8_STAGE(PG8_SA(0, 1), a2 + hstep, voffA);
            PG8_WAIT_L(8); PG8_BAR; PG8_WAIT_L(0); PG8_MMA(0, 0, At, B0); PG8_BAR; PG8_SCHED;
            PG8_LDB(B1, 1, 1); PG8_STAGE(PG8_SB(1, 0), b3, voffB);
            PG8_BAR; PG8_WAIT_L(0); PG8_MMA(0, 1, At, B1); PG8_BAR;
            PG8_LDA(At, 1, 1); PG8_STAGE(PG8_SA(1, 0), a3, voffA);
            PG8_BAR; PG8_WAIT_L(0); PG8_MMA(1, 0, At, B0); PG8_BAR; PG8_SCHED;
            PG8_STAGE(PG8_SB(1, 1), b3 + hstep, voffB);
            PG8_WAIT_V(6); PG8_BAR; PG8_MMA(1, 1, At, B1); PG8_BAR;
            }
        }
        if constexpr (ALIGN_EPI) { if (wr == 0) PG8_BAR; }
        if constexpr (!Epi::AFTER_DRAIN) { E(acc, cur, wr, wc, fr, fq); S.done(cur); }
        if (!has_next) break;
#pragma unroll
        for (int a = 0; a < 2; ++a)
#pragma unroll
            for (int b = 0; b < 2; ++b)
#pragma unroll
                for (int m = 0; m < 4; ++m)
#pragma unroll
                    for (int n = 0; n < 2; ++n) acc[a][b][m][n] = (f32x4){0.f, 0.f, 0.f, 0.f};
        cur = nxt; cA = nA; cB = nB; ++ui;
        if constexpr (ALIGN_EPI) { if (wr == 1) PG8_BAR; }
    }
    PG8_WAIT_V(0);
    if constexpr (!ALIGN_EPI) { if (wr == 0) PG8_BAR; }
    PG8_BAR;
    if constexpr (Epi::AFTER_DRAIN) { E.fused(acc, cur, wr, wc, fr, fq, lds, wid, lane); S.done(cur); }
#undef PG8_SA
#undef PG8_SB
#undef PG8_STAGE
#undef PG8_LDA
#undef PG8_LDB
#undef PG8_MMA
#undef PG8_WAIT_V
#undef PG8_WAIT_L
#undef PG8_BAR
#undef PG8_SCHED
}
}

#ifndef REP_P0
#define REP_P0 1
#endif
#ifndef REP_P1
#define REP_P1 1
#endif
#ifndef REP_P2
#define REP_P2 1
#endif
#ifndef REP_P3
#define REP_P3 1
#endif
#ifndef REP_P4
#define REP_P4 1
#endif
#ifndef REP_P6
#define REP_P6 1
#endif
#ifndef REP_P7
#define REP_P7 1
#endif
#ifndef REP_SYNC
#define REP_SYNC 1
#endif
constexpr int NWAVES = 8;
constexpr int BATCH = 2, SEQ = 8192, DM = 1024, M = BATCH * SEQ;
constexpr int IN_W = 5376, DFF = 2816, MEMLEN = 256;
constexpr int PQ_LD = 1792;
constexpr float RMS_EPS = 1e-6f;
constexpr float SB_STOP = -110.0f;

constexpr size_t MiB = 1u << 20;
constexpr size_t WS_SS = 0;
constexpr size_t WS_MK = 1 * MiB, WS_MVT = WS_MK + 256 * 1024, WS_MEMN = WS_MK + 512 * 1024;
constexpr size_t WS_WIN = 3 * MiB, WS_WFI = 14 * MiB, WS_WFO = 25 * MiB, WS_WO = 31 * MiB, WS_WSO = 33 * MiB, WS_WXO = 34 * MiB, WS_WEFF = 35 * MiB, WS_WMK = 36 * MiB;
constexpr size_t WS_XN = 40 * MiB;
constexpr size_t WS_MIXED = 40 * MiB, WS_SBO = 56 * MiB, WS_XO = 72 * MiB;
constexpr size_t WS_GATES = 80 * MiB;
constexpr size_t WS_PQ = 176 * MiB, WS_VT = 232 * MiB;
constexpr size_t WS_MERGED = 176 * MiB, WS_PART = 208 * MiB;
constexpr size_t WS_ACT = 80 * MiB;
constexpr size_t WS_FF = 168 * MiB;
constexpr size_t WS_BAR = 2 * MiB + 640 * 1024;
constexpr size_t WS_END = 248 * MiB;
constexpr int MISC_OFF = 131072;
constexpr int LDS_BYTES = 135168;

#define LAS __attribute__((address_space(3)))
typedef unsigned short bf16;
typedef unsigned v4u __attribute__((ext_vector_type(4)));
typedef unsigned v2u __attribute__((ext_vector_type(2)));
typedef float f32x4 __attribute__((ext_vector_type(4)));
typedef float f32x16 __attribute__((ext_vector_type(16)));
typedef short bf16x8 __attribute__((ext_vector_type(8)));
typedef short s16x4 __attribute__((ext_vector_type(4)));
using pg8::pk_bf16; using pg8::bf_lo; using pg8::bf_hi;
#define MFMA32(a, b, c) __builtin_amdgcn_mfma_f32_32x32x16_bf16((a), (b), (c), 0, 0, 0)

#define XB_TMO      128
#define XB_XCNT(j)  (256  + 64 * (j))
#define XB_XSUB(j)  (1280 + 64 * (j))
#define XB_XGEN(j)  (2304 + 64 * (j))
#define XB_TOP      3328
#define XB_TOPGEN   3392
#define XCD_BAR_WORDS 3456
#define XB_SPIN_CAP (1u << 18)

__device__ __forceinline__ unsigned xb_ld(unsigned* p)              { return __hip_atomic_load(p, __ATOMIC_RELAXED, __HIP_MEMORY_SCOPE_AGENT); }
__device__ __forceinline__ unsigned xb_add(unsigned* p, unsigned v) { return __hip_atomic_fetch_add(p, v, __ATOMIC_RELAXED, __HIP_MEMORY_SCOPE_AGENT); }
__device__ __forceinline__ unsigned xb_xcc_id() { return (unsigned)__builtin_amdgcn_s_getreg((3 << 11) | 20) & 0xFu; }
#define XB_SPIN(cond, bar) do { unsigned _sp = 0; while (cond) { __builtin_amdgcn_s_sleep(1); \
    if ((++_sp & 255u) == 0u) { if (xb_ld(&(bar)[XB_TMO])) break; if (_sp > XB_SPIN_CAP) { atomicAdd(&(bar)[XB_TMO], 1u); break; } } } } while (0)

struct XcdBarrier {
    unsigned* bar; unsigned x;
    volatile LAS unsigned* st;
};

__device__ __forceinline__ XcdBarrier xcd_barrier_post(unsigned* bar, volatile LAS unsigned* st) {
    XcdBarrier b; b.bar = bar; b.x = xb_xcc_id(); b.st = st;
    if (threadIdx.x == 0) (void)xb_add(&bar[XB_XCNT(b.x)], 1u);
    return b;
}
__device__ __forceinline__ void xcd_barrier_complete(unsigned* bar, unsigned x, unsigned& nloc, unsigned& nx) {
    const unsigned G = gridDim.x * gridDim.y * gridDim.z;
    unsigned sum, cnt, mine, sp = 0u;
    for (;;) {
        sum = 0u; cnt = 0u; mine = 0u;
#pragma unroll
        for (unsigned j = 0; j < 16; ++j) { const unsigned c = xb_ld(&bar[XB_XCNT(j)]); sum += c; cnt += (c > 0u) ? 1u : 0u; mine = (j == x) ? c : mine; }
        if (sum == G) break;
        __builtin_amdgcn_s_sleep(1);
        if ((++sp & 255u) == 0u) { if (xb_ld(&bar[XB_TMO])) break; if (sp > XB_SPIN_CAP) { atomicAdd(&bar[XB_TMO], 1u); break; } }
    }
    nloc = mine > 0u ? mine : 1u; nx = cnt > 0u ? cnt : 1u;
}

__device__ __forceinline__ void xcd_barrier(const XcdBarrier& b) {
    asm volatile("s_waitcnt vmcnt(0)" ::: "memory");
    __syncthreads();
    if (threadIdx.x == 0) {
        unsigned* bar = b.bar;
        __builtin_amdgcn_s_waitcnt(0);
        unsigned nloc = b.st[0], nx = b.st[1];
        if (nloc == 0u) { xcd_barrier_complete(bar, b.x, nloc, nx); b.st[0] = nloc; b.st[1] = nx; }
        const unsigned old = xb_add(&bar[XB_XSUB(b.x)], 1u);
        const unsigned gen = old / nloc;
        if (old + 1u == (gen + 1u) * nloc) {
            __builtin_amdgcn_fence(__ATOMIC_RELEASE, "agent");
            asm volatile("s_waitcnt vmcnt(0)" ::: "memory");
            const unsigned og = xb_add(&bar[XB_TOP], 1u);
            const unsigned tg = og / nx;
            if (og + 1u == (tg + 1u) * nx) xb_add(&bar[XB_TOPGEN], 1u);
            else XB_SPIN(xb_ld(&bar[XB_TOPGEN]) == tg, bar);
            __builtin_amdgcn_fence(__ATOMIC_ACQUIRE, "agent");
            xb_add(&bar[XB_XGEN(b.x)], 1u);
            asm volatile("s_waitcnt vmcnt(0)" ::: "memory");
        } else {
            XB_SPIN(xb_ld(&bar[XB_XGEN(b.x)]) == gen, bar);
            __builtin_amdgcn_fence(__ATOMIC_ACQUIRE, "agent");
            asm volatile("s_waitcnt vmcnt(0)" ::: "memory");
        }
    }
    __syncthreads();
}

__device__ __forceinline__ float wave_sum(float v) {
#pragma unroll
    for (int o = 1; o < 64; o <<= 1) v += __shfl_xor(v, o);
    return v;
}
__device__ __forceinline__ int crow(int r, int hi) { return (r & 3) + 8 * (r >> 2) + 4 * hi; }

struct Args { const float* in[17]; float* out; unsigned char* ws; };
__device__ __forceinline__ int fresh_tid() { int t = threadIdx.x; asm volatile("" : "+v"(t)); return t; }
__device__ __forceinline__ unsigned char* fresh_ptr(unsigned char* p) { asm volatile("" : "+s"(p)); return p; }
enum { I_X = 0, I_MEM, I_NMIXPRE, I_WIN, I_WPMIX, I_PSCALE, I_WPO, I_WSBO, I_NMEM, I_WMEMKV, I_WXO, I_WOUT, I_NMIXPOST, I_NFFNPRE, I_WFFNIN, I_WFFNOUT, I_NFFNPOST };

__device__ __forceinline__ void p0_transpose_item(const float* W, int K, int N, bf16* WT, int dst_row, LAS float* scr, int k0, int n0, int lane) {
#pragma unroll 8
    for (int i = 0; i < 32; ++i) { const int kk = 2 * i + (lane >> 5); scr[kk * 33 + (lane & 31)] = W[(size_t)(k0 + kk) * N + n0 + (lane & 31)]; }
    asm volatile("s_waitcnt lgkmcnt(0)" ::: "memory");
    const int c = lane & 7;
#pragma unroll
    for (int j = 0; j < 4; ++j) { const int n = (lane >> 3) + 8 * j; const LAS float* s = scr + (8 * c) * 33 + n;
        v4u o; o.x = pk_bf16(s[0 * 33], s[1 * 33]); o.y = pk_bf16(s[2 * 33], s[3 * 33]); o.z = pk_bf16(s[4 * 33], s[5 * 33]); o.w = pk_bf16(s[6 * 33], s[7 * 33]);
        *(v4u*)(WT + (size_t)(dst_row + n) * K + k0 + 8 * c) = o; }
    asm volatile("s_waitcnt lgkmcnt(0)" ::: "memory");
}
__device__ __forceinline__ void p0_tr(const float* W, int K, int N, bf16* WT, LAS float* scr, int item, int lane) {
    const int nblk = N / 32, kb = item / nblk, nb = item % nblk;
    p0_transpose_item(W, K, N, WT, 32 * nb, scr, 64 * kb, 32 * nb, lane);
}
__device__ __forceinline__ void rms_row_to_bf16(const float* xrow, const float* g, bf16* orow, int lane) {
    const f32x4* xr = (const f32x4*)xrow + lane; const f32x4* gr = (const f32x4*)g + lane;
    f32x4 v[4]; float s = 0.f;
#pragma unroll
    for (int j = 0; j < 4; ++j) { v[j] = xr[64 * j]; s += (v[j].x * v[j].x + v[j].y * v[j].y) + (v[j].z * v[j].z + v[j].w * v[j].w); }
    const float rstd = rsqrtf(wave_sum(s) * (1.f / DM) + RMS_EPS);
    v2u* o8 = (v2u*)orow + lane;
#pragma unroll
    for (int j = 0; j < 4; ++j) { const f32x4 gg = gr[64 * j]; v2u w; w.x = pk_bf16(v[j].x * rstd * gg.x, v[j].y * rstd * gg.y); w.y = pk_bf16(v[j].z * rstd * gg.z, v[j].w * rstd * gg.w); o8[64 * j] = w; }
}

constexpr float SB_C2 = 0.125f * 1.4426950408889634f;
constexpr float SB_STOP2 = SB_STOP * 1.4426950408889634f;
struct KVFrag { bf16x8 k[4]; s16x4 vlo[2][2], vhi[2][2]; };
__device__ __forceinline__ void kv_load(KVFrag& f, const bf16* kp  , int kpitch_unused, const bf16* vp  , size_t vhalf  ) {
#pragma unroll
    for (int d0 = 0; d0 < 4; ++d0) f.k[d0] = *(const bf16x8*)(kp + d0 * 16);
#pragma unroll
    for (int db = 0; db < 2; ++db)
#pragma unroll
        for (int s = 0; s < 2; ++s) { const bf16* v = vp + db * vhalf + 16 * s; f.vlo[db][s] = *(const s16x4*)v; f.vhi[db][s] = *(const s16x4*)(v + 8); }
}
__device__ __forceinline__ void pv_step(f32x16& o0, f32x16& o1, const float (&a)[16], const KVFrag& f) {
#pragma unroll
    for (int s = 0; s < 2; ++s) {
        v4u pw; pw.x = pk_bf16(a[8 * s], a[8 * s + 1]); pw.y = pk_bf16(a[8 * s + 2], a[8 * s + 3]); pw.z = pk_bf16(a[8 * s + 4], a[8 * s + 5]); pw.w = pk_bf16(a[8 * s + 6], a[8 * s + 7]);
        const bf16x8 pf = __builtin_bit_cast(bf16x8, pw);
        const bf16x8 v0 = (bf16x8){f.vlo[0][s][0], f.vlo[0][s][1], f.vlo[0][s][2], f.vlo[0][s][3], f.vhi[0][s][0], f.vhi[0][s][1], f.vhi[0][s][2], f.vhi[0][s][3]};
        const bf16x8 v1 = (bf16x8){f.vlo[1][s][0], f.vlo[1][s][1], f.vlo[1][s][2], f.vlo[1][s][3], f.vhi[1][s][0], f.vhi[1][s][1], f.vhi[1][s][2], f.vhi[1][s][3]};
        o0 = MFMA32(v0, pf, o0); o1 = MFMA32(v1, pf, o1);
    }
}
__device__ __forceinline__ void sb_unit(const bf16* PQ, const bf16* VT, bf16* SBO, int b, int h, int qb, int lane) {
    const int r32 = lane & 31, hi = lane >> 5;
    const size_t rowbase = (size_t)b * SEQ; const int q0 = qb * 32;
    bf16x8 qf[4];
    { const bf16* qp = PQ + (rowbase + q0 + r32) * PQ_LD + 512 + h * 64 + hi * 8;
#pragma unroll
      for (int d0 = 0; d0 < 4; ++d0) qf[d0] = *(const bf16x8*)(qp + d0 * 16); }
    f32x16 o0, o1;
#pragma unroll
    for (int r = 0; r < 16; ++r) { o0[r] = 0.f; o1[r] = 0.f; }
    float R = 0.f;
    const bf16* kbase = PQ + (rowbase + r32) * PQ_LD + 1024 + h * 64 + hi * 8;
    const bf16* vbase = VT + ((size_t)((b * 8 + h) * 64 + r32)) * SEQ + 4 * hi;
    KVFrag cur, nxt;
    kv_load(cur, kbase + (size_t)q0 * PQ_LD, 0, vbase + q0, (size_t)32 * SEQ);
    for (int k0 = q0;; k0 -= 32) {
        const int kn = k0 >= 32 ? k0 - 32 : 0;
        kv_load(nxt, kbase + (size_t)kn * PQ_LD, 0, vbase + kn, (size_t)32 * SEQ);
        f32x16 p;
#pragma unroll
        for (int r = 0; r < 16; ++r) p[r] = 0.f;
#pragma unroll
        for (int d0 = 0; d0 < 4; ++d0) p = MFMA32(cur.k[d0], qf[d0], p);
        const bool diag = (k0 == q0);
        float l[16];
#pragma unroll
        for (int r = 0; r < 16; ++r) {
            const float t = p[r] * SB_C2; p[r] = t;
            const float sp = fmaxf(t, 0.f) + __log2f(1.0f + __builtin_amdgcn_exp2f(-fabsf(t)));
            l[r] = (!diag || (crow(r, hi) < r32)) ? -sp : 0.f;
        }
        float sc[4], sq[4];
#pragma unroll
        for (int c = 0; c < 4; ++c) { sc[c] = (l[4 * c] + l[4 * c + 1]) + (l[4 * c + 2] + l[4 * c + 3]); sq[c] = __shfl_xor(sc[c], 32); }
        const float T0 = sc[0] + sq[0], T1 = sc[1] + sq[1], T2 = sc[2] + sq[2], T3 = sc[3] + sq[3];
        float U[4]; U[3] = 0.f; U[2] = T3; U[1] = T3 + T2; U[0] = U[1] + T1;
        const float tot = U[0] + T0;
        float a[16];
#pragma unroll
        for (int c = 0; c < 4; ++c) {
            const float base = R + U[c] + (hi == 0 ? sq[c] : 0.f);
            const float i3 = base + l[4 * c + 3], i2 = i3 + l[4 * c + 2], i1 = i2 + l[4 * c + 1], i0 = i1 + l[4 * c];
            a[4 * c + 3] = __builtin_amdgcn_exp2f(p[4 * c + 3] + i3); a[4 * c + 2] = __builtin_amdgcn_exp2f(p[4 * c + 2] + i2);
            a[4 * c + 1] = __builtin_amdgcn_exp2f(p[4 * c + 1] + i1); a[4 * c] = __builtin_amdgcn_exp2f(p[4 * c] + i0);
        }
        if (diag) {
#pragma unroll
            for (int r = 0; r < 16; ++r) a[r] = (crow(r, hi) < r32) ? a[r] : 0.f;
        }
        R += tot;
        pv_step(o0, o1, a, cur);
        if (k0 == 0 || __all(R < SB_STOP2)) break;
        cur = nxt;
    }
    bf16* op = SBO + (rowbase + q0 + r32) * 512 + h * 64 + 4 * hi;
#pragma unroll
    for (int g4 = 0; g4 < 4; ++g4) {
        v2u w0; w0.x = pk_bf16(o0[4 * g4], o0[4 * g4 + 1]); w0.y = pk_bf16(o0[4 * g4 + 2], o0[4 * g4 + 3]); *(v2u*)(op + 8 * g4) = w0;
        v2u w1; w1.x = pk_bf16(o1[4 * g4], o1[4 * g4 + 1]); w1.y = pk_bf16(o1[4 * g4 + 2], o1[4 * g4 + 3]); *(v2u*)(op + 32 + 8 * g4) = w1;
    }
}
__device__ __forceinline__ void xattn_unit(const bf16* PQ, const bf16* MK, const bf16* MVT, bf16* XO, int b, int h, int qb, int lane) {
    const int r32 = lane & 31, hi = lane >> 5;
    const size_t row = (size_t)b * SEQ + qb * 32 + r32;
    bf16x8 qf[4];
    { const bf16* qp = PQ + row * PQ_LD + 1536 + h * 64 + hi * 8;
#pragma unroll
      for (int d0 = 0; d0 < 4; ++d0) qf[d0] = *(const bf16x8*)(qp + d0 * 16); }
    f32x16 o0, o1;
#pragma unroll
    for (int r = 0; r < 16; ++r) { o0[r] = 0.f; o1[r] = 0.f; }
    float mrun = -INFINITY, lrun = 0.f;
    const bf16* kbase = MK + ((size_t)b * MEMLEN + r32) * 256 + h * 64 + hi * 8;
    const bf16* vbase = MVT + ((size_t)((b * 4 + h) * 64 + r32)) * MEMLEN + 4 * hi;
    KVFrag cur, nxt;
    kv_load(cur, kbase, 0, vbase, (size_t)32 * MEMLEN);
#pragma unroll 1
    for (int k0 = 0; k0 < MEMLEN; k0 += 32) {
        const int kn = k0 + 32 < MEMLEN ? k0 + 32 : k0;
        kv_load(nxt, kbase + (size_t)kn * 256, 0, vbase + kn, (size_t)32 * MEMLEN);
        f32x16 p;
#pragma unroll
        for (int r = 0; r < 16; ++r) p[r] = 0.f;
#pragma unroll
        for (int d0 = 0; d0 < 4; ++d0) p = MFMA32(cur.k[d0], qf[d0], p);
        float tmax = -INFINITY;
#pragma unroll
        for (int r = 0; r < 16; ++r) { p[r] *= SB_C2; tmax = fmaxf(tmax, p[r]); }
        tmax = fmaxf(tmax, __shfl_xor(tmax, 32));
        const float mnew = fmaxf(mrun, tmax), alpha = __builtin_amdgcn_exp2f(mrun - mnew);
        mrun = mnew; lrun *= alpha;
#pragma unroll
        for (int r = 0; r < 16; ++r) { o0[r] *= alpha; o1[r] *= alpha; }
        float a[16];
#pragma unroll
        for (int r = 0; r < 16; ++r) { a[r] = __builtin_amdgcn_exp2f(p[r] - mnew); lrun += a[r]; }
        pv_step(o0, o1, a, cur);
        cur = nxt;
    }
    const float inv = 1.0f / (lrun + __shfl_xor(lrun, 32));
    bf16* op = XO + row * 256 + h * 64 + 4 * hi;
#pragma unroll
    for (int g4 = 0; g4 < 4; ++g4) {
        v2u w0; w0.x = pk_bf16(o0[4 * g4] * inv, o0[4 * g4 + 1] * inv); w0.y = pk_bf16(o0[4 * g4 + 2] * inv, o0[4 * g4 + 3] * inv); *(v2u*)(op + 8 * g4) = w0;
        v2u w1; w1.x = pk_bf16(o1[4 * g4] * inv, o1[4 * g4 + 1] * inv); w1.y = pk_bf16(o1[4 * g4 + 2] * inv, o1[4 * g4 + 3] * inv); *(v2u*)(op + 32 + 8 * g4) = w1;
    }
}
__device__ __forceinline__ void pool_token(const bf16* PQ, bf16* MIXED, int row, int lane) {
    const int pos = row & (SEQ - 1), g = lane >> 4, w = 2 << g;
    const int cnt = (pos + 1 < w) ? pos + 1 : w;
    const bf16* p = PQ + (size_t)row * PQ_LD + lane * 8;
    float s[8];
#pragma unroll
    for (int j = 0; j < 8; ++j) s[j] = 0.f;
    v4u self = {0u, 0u, 0u, 0u};
#pragma unroll
    for (int i = 0; i < 16; ++i) { const bool on = i < cnt; const v4u v = *(const v4u*)(p - (size_t)(on ? i : 0) * PQ_LD); const float m = on ? 1.f : 0.f;
        if (i == 0) self = v;
        s[0] += m * bf_lo(v.x); s[1] += m * bf_hi(v.x); s[2] += m * bf_lo(v.y); s[3] += m * bf_hi(v.y); s[4] += m * bf_lo(v.z); s[5] += m * bf_hi(v.z); s[6] += m * bf_lo(v.w); s[7] += m * bf_hi(v.w); }
    const float ic = 1.0f / (float)cnt;
    v4u o;
    o.x = pk_bf16(s[0] * ic - bf_lo(self.x), s[1] * ic - bf_hi(self.x)); o.y = pk_bf16(s[2] * ic - bf_lo(self.y), s[3] * ic - bf_hi(self.y));
    o.z = pk_bf16(s[4] * ic - bf_lo(self.z), s[5] * ic - bf_hi(self.z)); o.w = pk_bf16(s[6] * ic - bf_lo(self.w), s[7] * ic - bf_hi(self.w));
    *(v4u*)(MIXED + (size_t)row * 512 + lane * 8) = o;
}

__global__ void __launch_bounds__(NWAVES * 64, 2) fwd_megakernel(Args args) {
    extern __shared__ __attribute__((aligned(16))) unsigned char lds_raw[];
    cg::grid_group grid = cg::this_grid();
    LAS unsigned char* lds = (LAS unsigned char*)lds_raw;
    const int G = gridDim.x, bx = blockIdx.x;
    {
        const int t0 = fresh_tid();
        if (t0 < 2) ((volatile LAS unsigned*)(lds + MISC_OFF))[t0] = 0u;
        if (bx == 0) { unsigned* bw = (unsigned*)(fresh_ptr(args.ws) + WS_BAR); for (int i = t0; i < XCD_BAR_WORDS; i += NWAVES * 64) bw[i] = 0u; }
        __syncthreads();
    }
    XcdBarrier bar; bar.bar = (unsigned*)(args.ws + WS_BAR); bar.x = 0; bar.st = (volatile LAS unsigned*)(lds + MISC_OFF);
#define PHASE_VARS() const int tid_ = fresh_tid(), lane = tid_ & 63, wave = __builtin_amdgcn_readfirstlane(tid_ >> 6); const int gw = bx * NWAVES + wave, NGW = G * NWAVES; unsigned char* ws = fresh_ptr(args.ws); (void)lane; (void)gw; (void)NGW; (void)ws
#define WSP(T, off) ((T*)(ws + (off)))
#define GSYNC() do { for (int rs_ = 0; rs_ < REP_SYNC; ++rs_) xcd_barrier(bar); } while (0)

    for (int rep_ = 0; rep_ < REP_P0; ++rep_)
    {
        PHASE_VARS();
        bf16* WIN_T = WSP(bf16, WS_WIN); bf16* WFI_T = WSP(bf16, WS_WFI); bf16* WFO_T = WSP(bf16, WS_WFO); bf16* WO_T = WSP(bf16, WS_WO);
        bf16* WSO_T = WSP(bf16, WS_WSO); bf16* WXO_T = WSP(bf16, WS_WXO); bf16* WEFF_T = WSP(bf16, WS_WEFF); bf16* WMK_T = WSP(bf16, WS_WMK);
        bf16* XN = WSP(bf16, WS_XN); bf16* MEMN = WSP(bf16, WS_MEMN);
        LAS float* scr = (LAS float*)(lds + wave * 16384);
        constexpr int I_IN = 16 * 168, I_FI = 16 * 176, I_FO = 44 * 32, I_O = 16 * 32, I_SO = 8 * 32, I_XO = 4 * 32, I_MK = 16 * 16, I_EFF = 1024;
        constexpr int NIT = I_IN + I_FI + I_FO + I_O + I_SO + I_XO + I_MK + I_EFF;
        for (int it = gw; it < NIT; it += NGW) {
            int r = it;
            if (r < I_IN) { p0_tr(args.in[I_WIN], 1024, IN_W, WIN_T, scr, r, lane); continue; } r -= I_IN;
            if (r < I_FI) {
                const int nblk = (2 * DFF) / 32, kb = r / nblk, nb = r % nblk, n0 = 32 * nb; const int up = n0 >= DFF ? 1 : 0, j = n0 - up * DFF;
                p0_transpose_item(args.in[I_WFFNIN], 1024, 2 * DFF, WFI_T, 256 * (j >> 7) + 128 * up + (j & 127), scr, 64 * kb, n0, lane); continue; } r -= I_FI;
            if (r < I_FO) { p0_tr(args.in[I_WFFNOUT], DFF, 1024, WFO_T, scr, r, lane); continue; } r -= I_FO;
            if (r < I_O) { p0_tr(args.in[I_WOUT], 1024, 1024, WO_T, scr, r, lane); continue; } r -= I_O;
            if (r < I_SO) { p0_tr(args.in[I_WSBO], 512, 1024, WSO_T, scr, r, lane); continue; } r -= I_SO;
            if (r < I_XO) { p0_tr(args.in[I_WXO], 256, 1024, WXO_T, scr, r, lane); continue; } r -= I_XO;
            if (r < I_MK) { p0_tr(args.in[I_WMEMKV], 1024, 512, WMK_T, scr, r, lane); continue; } r -= I_MK;
            {
                const int gc0 = (r >> 4) * 8, g = gc0 >> 7, n = (r & 15) * 64 + lane;
                const float* wm = args.in[I_WPMIX] + (size_t)gc0 * 128;
                const float* sc = args.in[I_PSCALE] + g * 128; const float* wpo = args.in[I_WPO] + (size_t)g * 128 * 1024 + n;
                float acc[8];
#pragma unroll
                for (int j = 0; j < 8; ++j) acc[j] = 0.f;
                for (int d = 0; d < 128; ++d) { const float w = wpo[(size_t)d * 1024] * sc[d];
#pragma unroll
                    for (int j = 0; j < 8; ++j) acc[j] += wm[j * 128 + d] * w; }
                v4u o; o.x = pk_bf16(acc[0], acc[1]); o.y = pk_bf16(acc[2], acc[3]); o.z = pk_bf16(acc[4], acc[5]); o.w = pk_bf16(acc[6], acc[7]);
                *(v4u*)(WEFF_T + (size_t)n * 512 + gc0) = o;
            }
        }
        for (int m = gw; m < M; m += NGW) rms_row_to_bf16(args.in[I_X] + (size_t)m * DM, args.in[I_NMIXPRE], XN + (size_t)m * DM, lane);
        for (int m = gw; m < BATCH * MEMLEN; m += NGW) rms_row_to_bf16(args.in[I_MEM] + (size_t)m * DM, args.in[I_NMEM], MEMN + (size_t)m * DM, lane);
    }
    grid.sync();
    bar = xcd_barrier_post((unsigned*)(args.ws + WS_BAR), (volatile LAS unsigned*)(lds + MISC_OFF));

    for (int rep_ = 0; rep_ < REP_P1; ++rep_)
    {
        PHASE_VARS();
        pg8::EpiProj E{WSP(bf16, WS_PQ), WSP(bf16, WS_GATES), WSP(bf16, WS_VT), WSP(bf16, WS_MK), WSP(bf16, WS_MVT), 0};
        { pg8::Gemm g{WSP(bf16, WS_XN), WSP(bf16, WS_WIN), M, IN_W, 1024}; pg8::StaticOrder S; S.init(M, IN_W, G, bx);
          pg8::gemm_phase<pg8::EpiProj, pg8::StaticOrder, true, true>(lds, g, S, E); }
        E.kind = 1;
        { pg8::Gemm g{WSP(bf16, WS_MEMN), WSP(bf16, WS_WMK), BATCH * MEMLEN, 512, 1024}; pg8::StaticOrder S; S.init(BATCH * MEMLEN, 512, G, (bx + G - (64 % G)) % G);
          pg8::gemm_phase<pg8::EpiProj, pg8::StaticOrder, true, true>(lds, g, S, E); }
    }
    GSYNC();

    for (int rep_ = 0; rep_ < REP_P2; ++rep_)
    {
        PHASE_VARS();
        const bf16* PQ = WSP(bf16, WS_PQ);
        for (int u = gw; u < 16 * 256; u += NGW) { const int bh = u >> 8, qb = u & 255; sb_unit(PQ, WSP(bf16, WS_VT), WSP(bf16, WS_SBO), bh >> 3, bh & 7, qb, lane); }
        for (int u = gw; u < 8 * 256; u += NGW) { const int bh = u >> 8, qb = u & 255; xattn_unit(PQ, WSP(bf16, WS_MK), WSP(bf16, WS_MVT), WSP(bf16, WS_XO), bh >> 2, bh & 3, qb, lane); }
        for (int r = gw; r < M; r += NGW) pool_token(PQ, WSP(bf16, WS_MIXED), r, lane);
    }
    GSYNC();

    for (int rep_ = 0; rep_ < REP_P3; ++rep_)
    {
        PHASE_VARS();
        for (int br = 0; br < 3; ++br) {
            const bf16* A = br == 0 ? WSP(bf16, WS_MIXED) : (br == 1 ? WSP(bf16, WS_SBO) : WSP(bf16, WS_XO)); const bf16* Bt = br == 0 ? WSP(bf16, WS_WEFF) : (br == 1 ? WSP(bf16, WS_WSO) : WSP(bf16, WS_WXO)); const int K = br == 2 ? 256 : 512;
            pg8::Gemm g{A, Bt, M, DM, K}; pg8::StaticOrder S; S.init(M, DM, G, bx);
            pg8::EpiGate E{WSP(bf16, WS_GATES) + br * 1024, br == 0 ? (const bf16*)nullptr : WSP(bf16, WS_PART), br == 2 ? WSP(bf16, WS_MERGED) : WSP(bf16, WS_PART)};
            pg8::gemm_phase<pg8::EpiGate, pg8::StaticOrder, true, true>(lds, g, S, E);
        }
    }
    GSYNC();

    for (int rep_ = 0; rep_ < REP_P4; ++rep_)
    {
        PHASE_VARS();
        pg8::Gemm g{WSP(bf16, WS_MERGED), WSP(bf16, WS_WO), M, DM, 1024}; pg8::StaticOrder S; S.init(M, DM, G, bx);
        pg8::EpiF32SS E{args.out, WSP(float, WS_SS)};
        pg8::gemm_phase<pg8::EpiF32SS, pg8::StaticOrder, true, true>(lds, g, S, E);
    }
    GSYNC();

    {
        PHASE_VARS();
        const float* SS = WSP(float, WS_SS); bf16* XN = WSP(bf16, WS_XN); float* out = args.out; const float* x = args.in[I_X];
        for (int m = gw; m < M; m += NGW) {
            const float ssv = lane < 16 ? SS[(size_t)m * 16 + lane] : 0.f;
            const float rstd = rsqrtf(wave_sum(ssv) * (1.f / DM) + RMS_EPS);
            f32x4* ur = (f32x4*)(out + (size_t)m * DM) + lane; const f32x4* xr = (const f32x4*)(x + (size_t)m * DM) + lane;
            const f32x4* gp = (const f32x4*)args.in[I_NMIXPOST] + lane; const f32x4* gf = (const f32x4*)args.in[I_NFFNPRE] + lane;
            f32x4 hv[4]; float s = 0.f;
#pragma unroll
            for (int j = 0; j < 4; ++j) { const f32x4 uv = ur[64 * j], xv = xr[64 * j], gg = gp[64 * j]; hv[j] = xv + uv * rstd * gg;
                s += (hv[j].x * hv[j].x + hv[j].y * hv[j].y) + (hv[j].z * hv[j].z + hv[j].w * hv[j].w); ur[64 * j] = hv[j]; }
            const float rstd2 = rsqrtf(wave_sum(s) * (1.f / DM) + RMS_EPS);
            v2u* o8 = (v2u*)(XN + (size_t)m * DM) + lane;
#pragma unroll
            for (int j = 0; j < 4; ++j) { const f32x4 gg = gf[64 * j]; v2u w; w.x = pk_bf16(hv[j].x * rstd2 * gg.x, hv[j].y * rstd2 * gg.y); w.y = pk_bf16(hv[j].z * rstd2 * gg.z, hv[j].w * rstd2 * gg.w); o8[64 * j] = w; }
        }
    }
    GSYNC();

    for (int rep_ = 0; rep_ < REP_P6; ++rep_)
    {
        PHASE_VARS();
        pg8::Gemm g{WSP(bf16, WS_XN), WSP(bf16, WS_WFI), M, 2 * DFF, 1024}; pg8::StaticOrder S; S.init(M, 2 * DFF, G, bx);
        pg8::EpiSwiGLU E{WSP(bf16, WS_ACT)};
        pg8::gemm_phase<pg8::EpiSwiGLU, pg8::StaticOrder, true, true>(lds, g, S, E);
    }
    GSYNC();

    for (int rep_ = 0; rep_ < REP_P7; ++rep_)
    {
        PHASE_VARS();
        pg8::Gemm g{WSP(bf16, WS_ACT), WSP(bf16, WS_WFO), M, DM, DFF}; pg8::StaticOrder S; S.init(M, DM, G, bx);
        pg8::EpiF32SS E{WSP(float, WS_FF), WSP(float, WS_SS)};
        pg8::gemm_phase<pg8::EpiF32SS, pg8::StaticOrder, true, true>(lds, g, S, E);
    }
    GSYNC();

    {
        PHASE_VARS();
        const float* SS = WSP(float, WS_SS); const float* FF = WSP(float, WS_FF); float* out = args.out;
        for (int m = gw; m < M; m += NGW) {
            const float ssv = lane < 16 ? SS[(size_t)m * 16 + lane] : 0.f;
            const float rstd = rsqrtf(wave_sum(ssv) * (1.f / DM) + RMS_EPS);
            f32x4* hr = (f32x4*)(out + (size_t)m * DM) + lane; const f32x4* fr = (const f32x4*)(FF + (size_t)m * DM) + lane;
            const f32x4* gp = (const f32x4*)args.in[I_NFFNPOST] + lane;
#pragma unroll
            for (int j = 0; j < 4; ++j) { const f32x4 fv = fr[64 * j], hv = hr[64 * j], gg = gp[64 * j]; hr[64 * j] = hv + fv * rstd * gg; }
        }
    }
}

extern "C" void kernel_launch(void* const* d_in, const int* in_sizes, int n_in, void* d_out, int out_size, void* d_ws, size_t ws_size, hipStream_t stream) {
    static int grid = 0;
    if (grid == 0) {
        if (n_in != 17 || in_sizes[0] != M * DM || out_size != M * DM || ws_size < WS_END) { fprintf(stderr, "kernel_launch: unexpected shapes (n_in %d, in0 %d, out %d, ws %zu); nothing launched\n", n_in, n_in > 0 ? in_sizes[0] : -1, out_size, ws_size); grid = -1; return; }
        int dev = 0, cus = 0, per_cu = 0;
        hipGetDevice(&dev);
        hipDeviceGetAttribute(&cus, hipDeviceAttributeMultiprocessorCount, dev);
        hipFuncSetAttribute((const void*)fwd_megakernel, hipFuncAttributeMaxDynamicSharedMemorySize, LDS_BYTES);
        hipOccupancyMaxActiveBlocksPerMultiprocessor(&per_cu, (const void*)fwd_megakernel, NWAVES * 64, LDS_BYTES);
        if (per_cu < 1) per_cu = 1;
        (void)hipGetLastError();
        grid = cus * per_cu;
    }
    if (grid < 0) return;
    Args a{};
    for (int i = 0; i < 17; ++i) a.in[i] = (const float*)d_in[i];
    a.out = (float*)d_out; a.ws = (unsigned char*)d_ws;
    void* kargs[] = {&a};
    hipError_t e = hipLaunchCooperativeKernel((const void*)fwd_megakernel, dim3(grid), dim3(NWAVES * 64), kargs, LDS_BYTES, stream);
    if (e != hipSuccess) fprintf(stderr, "cooperative launch failed: %s (grid %d)\n", hipGetErrorString(e), grid);
}
```
